# Optimizing an MI355X kernel written in HIP

```python
import math
import jax, jax.numpy as jnp
from jax import lax
import numpy as np

D_MODEL = 4096
BATCH = 4
SEQ = 2048
DEPTH = 2
DEC_BATCH = 32
DEC_SEQ = 8
PAST_LEN = 16384
PAGE_SIZE = 128

N_A_LAYERS = DEPTH // 2
N_B_LAYERS = DEPTH - N_A_LAYERS
H_A = 32
DK_A = 128
DV_A = 128
D_QK = H_A * DK_A
D_V = H_A * DV_A
C_CONV = 2 * D_QK + D_V
CONV_W = 4
DELTA_CHUNK = 64
A_PROJ = 2 * D_QK + 2 * D_V + 2 * H_A
H_B = 64
KV_HEADS_B = 8
GROUP_B = H_B // KV_HEADS_B
HEAD_DIM_B = 64
KV_WIDTH = KV_HEADS_B * HEAD_DIM_B
WINDOW = 128
ROT_DIM = HEAD_DIM_B // 4
ROPE_THETA = 500000.0
_FF_RAW = -(-8 * D_MODEL // 3)
D_FF = -(-_FF_RAW // 256) * 256
EPS = 1e-6

kernel_name = "yoco_gated_deltanet_swa_sinks_step"


def _rmsnorm(x, w):
    xf = x.astype(jnp.float32)
    y = xf * lax.rsqrt(jnp.mean(xf * xf, axis=-1, keepdims=True) + EPS)
    return (y * w.astype(jnp.float32)).astype(x.dtype)


def _l2norm(x):
    xf = x.astype(jnp.float32)
    return xf * lax.rsqrt(jnp.sum(xf * xf, axis=-1, keepdims=True) + EPS)


def _swiglu(xn, w_gu, w_down):
    gu = xn @ w_gu
    return (jax.nn.silu(gu[..., :D_FF]) * gu[..., D_FF:]) @ w_down


def _rope_partial(x, pos):
    half = ROT_DIM // 2
    inv_freq = jnp.power(ROPE_THETA, -jnp.arange(half, dtype=jnp.float32) * 2.0 / ROT_DIM)
    ang = pos[:, None] * inv_freq[None, :]
    cos = jnp.cos(ang)[:, None, :]
    sin = jnp.sin(ang)[:, None, :]
    xr = x[..., :ROT_DIM].astype(jnp.float32)
    x1, x2 = xr[..., :half], xr[..., half:]
    rot = jnp.concatenate([x1 * cos - x2 * sin, x2 * cos + x1 * sin], axis=-1)
    return jnp.concatenate([rot.astype(x.dtype), x[..., ROT_DIM:]], axis=-1)


def _gated_delta_rule(q, k, v, g, beta, h0):
    B, T, H, DK = q.shape
    DV = v.shape[-1]
    C = math.gcd(T, DELTA_CHUNK)
    N = T // C

    def blocks(a):
        a = a.astype(jnp.float32).reshape((B, N, C, H) + a.shape[3:])
        return jnp.moveaxis(jnp.moveaxis(a, 1, 0), 3, 2)

    causal = jnp.tril(jnp.ones((C, C), dtype=bool))
    strict = jnp.tril(jnp.ones((C, C), dtype=bool), k=-1)
    eye = jnp.eye(C, dtype=jnp.float32)

    def step(h, inp):
        qc, kc, vc, gc, bc = inp
        gcum = jnp.cumsum(gc, axis=-1)
        decay = jnp.exp(jnp.where(causal, gcum[..., :, None] - gcum[..., None, :], -jnp.inf))
        kk = jnp.einsum('bhcd,bhsd->bhcs', kc, kc)
        lower = jnp.where(strict, kk * decay * bc[..., :, None], 0.0) + eye
        rhs = vc * bc[..., None] - jnp.einsum('bhcd,bhde->bhce', kc * (bc * jnp.exp(gcum))[..., None], h)
        u = lax.linalg.triangular_solve(lower, rhs, left_side=True, lower=True)
        qk = jnp.einsum('bhcd,bhsd->bhcs', qc, kc) * decay
        o = (jnp.einsum('bhcd,bhde->bhce', qc * jnp.exp(gcum)[..., None], h)
             + jnp.einsum('bhcs,bhse->bhce', qk, u))
        g_last = gcum[..., -1:]
        h_new = (h * jnp.exp(g_last)[..., None]
                 + jnp.einsum('bhcd,bhce->bhde', kc * jnp.exp(g_last - gcum)[..., None], u))
        return h_new, o

    h_final, o = lax.scan(step, h0.astype(jnp.float32),
                          (blocks(q), blocks(k), blocks(v), blocks(g), blocks(beta)))
    o = jnp.moveaxis(jnp.moveaxis(o, 2, 3), 0, 1).reshape(B, T, H, DV)
    return o, h_final


def _delta_mixer(xn, conv_buf, h0, w_in, conv_w, a_log, dt_bias, o_norm_w, w_out):
    B, T, _ = xn.shape
    proj = xn @ w_in
    qkv = proj[..., :C_CONV]
    z = proj[..., C_CONV:C_CONV + D_V]
    b_raw = proj[..., C_CONV + D_V:C_CONV + D_V + H_A]
    a_raw = proj[..., C_CONV + D_V + H_A:]
    xp = jnp.concatenate([conv_buf.astype(qkv.dtype), qkv], axis=1)
    conv = sum(xp[:, i:i + T] * conv_w[i] for i in range(CONV_W))
    conv = jax.nn.silu(conv)
    new_buf = xp[:, T:]
    q = _l2norm(conv[..., :D_QK].reshape(B, T, H_A, DK_A)) * (DK_A ** -0.5)
    k = _l2norm(conv[..., D_QK:2 * D_QK].reshape(B, T, H_A, DK_A))
    v = conv[..., 2 * D_QK:].reshape(B, T, H_A, DV_A)
    beta = jax.nn.sigmoid(b_raw.astype(jnp.float32))
    g = -jnp.exp(a_log.astype(jnp.float32)) * jax.nn.softplus(a_raw.astype(jnp.float32) + dt_bias.astype(jnp.float32))
    o, h_final = _gated_delta_rule(q, k, v, g, beta, h0)
    o = _rmsnorm(o, o_norm_w) * jax.nn.silu(z.reshape(B, T, H_A, DV_A).astype(jnp.float32))
    y = o.reshape(B, T, D_V).astype(xn.dtype) @ w_out
    return y, new_buf, h_final


def _shared_kv(h, kv_norm, w_kv, k_norm, pos):
    B, T, _ = h.shape
    kv = _rmsnorm(h, kv_norm) @ w_kv
    k = kv[..., :KV_WIDTH].reshape(B, T, KV_HEADS_B, HEAD_DIM_B)
    v = kv[..., KV_WIDTH:].reshape(B, T, KV_HEADS_B, HEAD_DIM_B)
    k = _rope_partial(_rmsnorm(k, k_norm), pos)
    return k, v


def _sink_attention(q, k, v, mask, sinks):
    s = jnp.einsum('...qhgd,...shd->...hgqs', q, k, preferred_element_type=jnp.float32) * (HEAD_DIM_B ** -0.5)
    s = jnp.where(mask, s, -jnp.inf)
    sink = sinks.astype(jnp.float32).reshape(KV_HEADS_B, GROUP_B, 1, 1)
    m = jnp.maximum(jnp.max(s, axis=-1, keepdims=True), sink)
    p = jnp.exp(s - m)
    denom = jnp.sum(p, axis=-1, keepdims=True) + jnp.exp(sink - m)
    o = jnp.einsum('...hgqs,...shd->...qhgd', p / denom, v.astype(jnp.float32))
    return o.astype(q.dtype)


def _window_attn_prompt(q, k, v, sinks):
    B, T = q.shape[:2]
    NB = T // WINDOW
    qb = q.reshape(B, NB, WINDOW, KV_HEADS_B, GROUP_B, HEAD_DIM_B)

    def with_prev(a):
        ab = a.reshape(B, NB, WINDOW, KV_HEADS_B, HEAD_DIM_B)
        prev = jnp.concatenate([jnp.zeros_like(ab[:, :1]), ab[:, :-1]], axis=1)
        return jnp.concatenate([prev, ab], axis=2)

    kb, vb = with_prev(k), with_prev(v)
    blk = jnp.arange(NB)[:, None] * WINDOW
    q_pos = blk + jnp.arange(WINDOW)[None, :]
    k_pos = blk - WINDOW + jnp.arange(2 * WINDOW)[None, :]
    d = q_pos[:, :, None] - k_pos[:, None, :]
    mask = (d >= 0) & (d < WINDOW) & (k_pos[:, None, :] >= 0)
    o = _sink_attention(qb, kb, vb, mask[None, :, None, None], sinks)
    return o.reshape(B, T, H_B * HEAD_DIM_B)


def _window_attn_sample(q, k_ctx, v_ctx, sinks, pos_start):
    T = q.shape[1]
    W = k_ctx.shape[1] - T
    q_pos = pos_start + jnp.arange(T)
    k_pos = pos_start - W + jnp.arange(W + T)
    d = q_pos[:, None] - k_pos[None, :]
    mask = (d >= 0) & (d < WINDOW)
    o = _sink_attention(q, k_ctx, v_ctx, mask, sinks)
    return o.reshape(q.shape[0], T, H_B * HEAD_DIM_B)


def _trunk(x, ssm0, conv0, win_k0, win_v0, pos_start, is_prompt, w):
    B, T, _ = x.shape
    pos = pos_start + jnp.arange(T, dtype=jnp.float32)
    h = x
    ssm_out, conv_out = [], []
    for l in range(N_A_LAYERS):
        y, cbuf, hs = _delta_mixer(_rmsnorm(h, w['norm_mix'][l]), conv0[l], ssm0[l], w['a_w_in'][l],
                                   w['a_conv_w'][l], w['a_log'][l], w['a_dt_bias'][l],
                                   w['a_o_norm'][l], w['a_w_out'][l])
        h = h + y
        h = h + _swiglu(_rmsnorm(h, w['norm_ffn'][l]), w['ffn_w_gu'][l], w['ffn_w_down'][l])
        ssm_out.append(hs)
        conv_out.append(cbuf)
    k, v = _shared_kv(h, w['kv_norm'], w['w_kv'], w['k_norm'], pos)
    if is_prompt:
        wb = min(WINDOW, T)
        new_k, new_v = k[:, T - wb:], v[:, T - wb:]
    else:
        k_ctx = jnp.concatenate([win_k0.astype(k.dtype), k], axis=1)
        v_ctx = jnp.concatenate([win_v0.astype(v.dtype), v], axis=1)
        wb = win_k0.shape[1]
        new_k, new_v = k_ctx[:, T:], v_ctx[:, T:]
        assert new_k.shape[1] == wb
    for j in range(N_B_LAYERS):
        l = N_A_LAYERS + j
        hn = _rmsnorm(h, w['norm_mix'][l])
        q = (hn @ w['b_w_q'][j]).reshape(B, T, H_B, HEAD_DIM_B)
        q = _rope_partial(_rmsnorm(q, w['b_q_norm'][j]), pos).reshape(B, T, KV_HEADS_B, GROUP_B, HEAD_DIM_B)
        if is_prompt:
            o = _window_attn_prompt(q, k, v, w['b_sinks'][j])
        else:
            o = _window_attn_sample(q, k_ctx, v_ctx, w['b_sinks'][j], pos_start)
        h = h + o @ w['b_w_o'][j]
        h = h + _swiglu(_rmsnorm(h, w['norm_ffn'][l]), w['ffn_w_gu'][l], w['ffn_w_down'][l])
    return h, jnp.stack(ssm_out), jnp.stack(conv_out), new_k, new_v


def setup_inputs(seed: int = 0) -> dict:
    key = jax.random.key(seed)
    ks = jax.random.split(key, 24)
    f32 = jnp.float32

    def nrm(k, shape, scale):
        return jax.random.normal(k, shape, f32) * scale

    w_buf = min(WINDOW, PAST_LEN)
    return {
        "x_prompt": nrm(ks[0], (BATCH, SEQ, D_MODEL), 1.0),
        "x_sample": nrm(ks[1], (DEC_BATCH, DEC_SEQ, D_MODEL), 1.0),
        "state_ssm": nrm(ks[2], (N_A_LAYERS, DEC_BATCH, H_A, DK_A, DV_A), 0.05),
        "state_conv": nrm(ks[3], (N_A_LAYERS, DEC_BATCH, CONV_W - 1, C_CONV), 1.0),
        "cache_win_k": nrm(ks[4], (DEC_BATCH, w_buf, KV_HEADS_B, HEAD_DIM_B), 1.0),
        "cache_win_v": nrm(ks[5], (DEC_BATCH, w_buf, KV_HEADS_B, HEAD_DIM_B), 1.0),
        "norm_mix": 1.0 + nrm(ks[6], (DEPTH, D_MODEL), 0.02),
        "norm_ffn": 1.0 + nrm(ks[7], (DEPTH, D_MODEL), 0.02),
        "a_w_in": nrm(ks[8], (N_A_LAYERS, D_MODEL, A_PROJ), D_MODEL ** -0.5),
        "a_conv_w": nrm(ks[9], (N_A_LAYERS, CONV_W, C_CONV), CONV_W ** -0.5),
        "a_log": jnp.log(jax.random.uniform(ks[10], (N_A_LAYERS, H_A), f32, 1.0, 16.0)),
        "a_dt_bias": nrm(ks[11], (N_A_LAYERS, H_A), 0.1),
        "a_o_norm": 1.0 + nrm(ks[12], (N_A_LAYERS, DV_A), 0.02),
        "a_w_out": nrm(ks[13], (N_A_LAYERS, D_V, D_MODEL), D_V ** -0.5),
        "kv_norm": 1.0 + nrm(ks[14], (D_MODEL,), 0.02),
        "w_kv": nrm(ks[15], (D_MODEL, 2 * KV_WIDTH), D_MODEL ** -0.5),
        "k_norm": 1.0 + nrm(ks[16], (HEAD_DIM_B,), 0.02),
        "b_w_q": nrm(ks[17], (N_B_LAYERS, D_MODEL, H_B * HEAD_DIM_B), D_MODEL ** -0.5),
        "b_q_norm": 1.0 + nrm(ks[18], (N_B_LAYERS, HEAD_DIM_B), 0.02),
        "b_sinks": nrm(ks[19], (N_B_LAYERS, H_B), 1.0),
        "b_w_o": nrm(ks[20], (N_B_LAYERS, H_B * HEAD_DIM_B, D_MODEL), (H_B * HEAD_DIM_B) ** -0.5),
        "ffn_w_gu": nrm(ks[21], (DEPTH, D_MODEL, 2 * D_FF), D_MODEL ** -0.5),
        "ffn_w_down": nrm(ks[22], (DEPTH, D_FF, D_MODEL), D_FF ** -0.5),
    }


def reference(x_prompt, x_sample, state_ssm, state_conv, cache_win_k, cache_win_v,
              norm_mix, norm_ffn, a_w_in, a_conv_w, a_log, a_dt_bias, a_o_norm, a_w_out,
              kv_norm, w_kv, k_norm, b_w_q, b_q_norm, b_sinks, b_w_o, ffn_w_gu, ffn_w_down):
    w = dict(norm_mix=norm_mix, norm_ffn=norm_ffn, a_w_in=a_w_in, a_conv_w=a_conv_w,
             a_log=a_log, a_dt_bias=a_dt_bias, a_o_norm=a_o_norm, a_w_out=a_w_out,
             kv_norm=kv_norm, w_kv=w_kv, k_norm=k_norm, b_w_q=b_w_q, b_q_norm=b_q_norm,
             b_sinks=b_sinks, b_w_o=b_w_o, ffn_w_gu=ffn_w_gu, ffn_w_down=ffn_w_down)
    bp = x_prompt.shape[0]
    ssm0_p = jnp.zeros((N_A_LAYERS, bp, H_A, DK_A, DV_A), jnp.float32)
    conv0_p = jnp.zeros((N_A_LAYERS, bp, CONV_W - 1, C_CONV), x_prompt.dtype)
    y_prompt, ssm_p, conv_p, wk_p, wv_p = _trunk(x_prompt, ssm0_p, conv0_p, None, None, 0, True, w)
    y_sample, ssm_s, conv_s, wk_s, wv_s = _trunk(x_sample, state_ssm, state_conv, cache_win_k,
                                                 cache_win_v, PAST_LEN, False, w)
    return (y_prompt, y_sample, ssm_p, conv_p, wk_p, wv_p, ssm_s, conv_s, wk_s, wv_s)
```

```cpp
#include <hip/hip_runtime.h>
#include <cstdio>
#include <cstdint>
namespace pg8 {
#define PG8_LAS __attribute__((address_space(3)))
typedef unsigned short bf16_t;
typedef short bf16x8 __attribute__((ext_vector_type(8)));
typedef float f32x4 __attribute__((ext_vector_type(4)));
typedef unsigned u32x4 __attribute__((ext_vector_type(4)));
constexpr int BM = 256, BK = 64, HALF = 128, HTB = HALF * BK * 2  , STAGE_BYTES = 8 * HTB, NXCD = 8;

__host__ __device__ __forceinline__ int lds_byte(int r, int c) { const int st = (r >> 4) * 2 + (c >> 5), rr = r & 15, cc = c & 31, ob = rr * 64 + cc * 2; return st * 1024 + (ob ^ (((ob >> 9) & 1) << 5)); }
__host__ __device__ __forceinline__ void stage_rc(int b, int& R, int& C) { const int st = b / 1024, sb = b % 1024, swz = sb ^ (((sb >> 9) & 1) << 5); R = (st >> 1) * 16 + swz / 64; C = (st & 1) * 32 + (swz % 64) / 2; }
__host__ __device__ __forceinline__ int perm32(int rho) { const int n = rho >> 4, i = rho & 15; return 8 * (i >> 2) + 4 * n + (i & 3); }

struct Unit { int pm, pn; };
struct Gemm { const bf16_t* A; const bf16_t* Bt; int M, N, K, ld; };

struct StaticOrder {
    int nM, nN, nwg, G, c;
    __host__ __device__ void init(int M, int N, int G_, int c_) { nM = M / BM; nN = N / BM; nwg = nM * nN; G = G_; c = c_; }
    __host__ __device__ bool next(int i, Unit& u) const {
        const int x = c & 7, p = 32 * i + (c >> 3), s = p - 4 * nN;
        if (s < 0) { u.pn = p >> 2; u.pm = 4 * x + (p & 3); } else { if (!(nM & 1)) return false; u.pn = x + 8 * s; u.pm = nM - 1; }
        return u.pn < nN;
    }
    __device__ __forceinline__ void a_ready(const Unit&) const {}
    __device__ __forceinline__ void done(const Unit&) const {}
};

__device__ __forceinline__ unsigned cvt_pk_bf16(float lo, float hi) { unsigned r; asm volatile("v_cvt_pk_bf16_f32 %0, %1, %2" : "=v"(r) : "v"(lo), "v"(hi)); return r; }
struct EpiF32 {
    static constexpr bool PERM = false, AFTER_DRAIN = false;
    float* C; int ldc;
    __device__ __forceinline__ void operator()(const f32x4 (&acc)[2][2][4][2], const Unit& u, int wr, int wc, int fr, int fq) const {
        const int row0 = u.pm * BM + wr * 64 + fr, col0 = u.pn * BM + wc * 32 + 4 * fq;
#pragma unroll
        for (int ai = 0; ai < 2; ++ai)
#pragma unroll
            for (int m = 0; m < 4; ++m) { float* rowp = C + (size_t)(row0 + ai * HALF + m * 16) * ldc + col0;
#pragma unroll
                for (int bj = 0; bj < 2; ++bj)
#pragma unroll
                    for (int n = 0; n < 2; ++n) *(f32x4*)(rowp + bj * HALF + n * 16) = acc[ai][bj][m][n]; }
    }
};
struct EpiRes {
    static constexpr bool PERM = false, AFTER_DRAIN = false;
    const float* baseP; const float* baseS; int split_pm; float* out; int ldc;
    __device__ __forceinline__ void operator()(const f32x4 (&acc)[2][2][4][2], const Unit& u, int wr, int wc, int fr, int fq) const {
        const int row0 = u.pm * BM + wr * 64 + fr, col0 = u.pn * BM + wc * 32 + 4 * fq;
        const bool sp = u.pm >= split_pm; const float* bb = sp ? baseS : baseP; const int brow0 = sp ? row0 - split_pm * BM : row0;
#pragma unroll
        for (int ai = 0; ai < 2; ++ai)
#pragma unroll
            for (int m = 0; m < 4; ++m) { float* rowp = out + (size_t)(row0 + ai * HALF + m * 16) * ldc + col0; const float* bp = bb + (size_t)(brow0 + ai * HALF + m * 16) * ldc + col0;
                f32x4 bv[2][2];
#pragma unroll
                for (int bj = 0; bj < 2; ++bj)
#pragma unroll
                    for (int n = 0; n < 2; ++n) bv[bj][n] = *(const f32x4*)(bp + bj * HALF + n * 16);
#pragma unroll
                for (int bj = 0; bj < 2; ++bj)
#pragma unroll
                    for (int n = 0; n < 2; ++n) *(f32x4*)(rowp + bj * HALF + n * 16) = bv[bj][n] + acc[ai][bj][m][n]; }
    }
};
template <bool INF, bool OUTF>
struct EpiResT {
    static constexpr bool PERM = true, AFTER_DRAIN = false;
    const float* basef; float* outf; bf16_t* hb; int ldc;
    __device__ __forceinline__ void operator()(const f32x4 (&acc)[2][2][4][2], const Unit& u, int wr, int wc, int fr, int fq) const {
        const int row0 = u.pm * BM + wr * 64 + fr, col0 = u.pn * BM + wc * 32 + 8 * fq;
#pragma unroll
        for (int ai = 0; ai < 2; ++ai)
#pragma unroll
            for (int m = 0; m < 4; ++m) { const size_t ro = (size_t)(row0 + ai * HALF + m * 16) * ldc + col0;
                f32x4 bv[2][2];
#pragma unroll
                for (int bj = 0; bj < 2; ++bj) { const size_t o = ro + bj * HALF;
                    if constexpr (INF) { bv[bj][0] = *(const f32x4*)(basef + o); bv[bj][1] = *(const f32x4*)(basef + o + 4); }
                    else { const u32x4 w = *(const u32x4*)(hb + o);
                        bv[bj][0] = (f32x4){__builtin_bit_cast(float, w.x << 16), __builtin_bit_cast(float, w.x & 0xffff0000u), __builtin_bit_cast(float, w.y << 16), __builtin_bit_cast(float, w.y & 0xffff0000u)};
                        bv[bj][1] = (f32x4){__builtin_bit_cast(float, w.z << 16), __builtin_bit_cast(float, w.z & 0xffff0000u), __builtin_bit_cast(float, w.w << 16), __builtin_bit_cast(float, w.w & 0xffff0000u)}; } }
#pragma unroll
                for (int bj = 0; bj < 2; ++bj) { const size_t o = ro + bj * HALF; const f32x4 y0 = bv[bj][0] + acc[ai][bj][m][0], y1 = bv[bj][1] + acc[ai][bj][m][1];
                    if constexpr (OUTF) { *(f32x4*)(outf + o) = y0; *(f32x4*)(outf + o + 4) = y1; }
                    else { u32x4 w; w.x = cvt_pk_bf16(y0[0], y0[1]); w.y = cvt_pk_bf16(y0[2], y0[3]); w.z = cvt_pk_bf16(y1[0], y1[1]); w.w = cvt_pk_bf16(y1[2], y1[3]); *(u32x4*)(hb + o) = w; } } }
    }
};
struct EpiAtomic {
    static constexpr bool PERM = false, AFTER_DRAIN = false;
    float* out; int ldc;
    __device__ __forceinline__ void operator()(const f32x4 (&acc)[2][2][4][2], const Unit& u, int wr, int wc, int fr, int fq) const {
        const int row0 = u.pm * BM + wr * 64 + fr, col0 = u.pn * BM + wc * 32 + 4 * fq;
#pragma unroll
        for (int ai = 0; ai < 2; ++ai)
#pragma unroll
            for (int m = 0; m < 4; ++m) { float* rowp = out + (size_t)(row0 + ai * HALF + m * 16) * ldc + col0;
#pragma unroll
                for (int bj = 0; bj < 2; ++bj)
#pragma unroll
                    for (int n = 0; n < 2; ++n)
#pragma unroll
                        for (int j = 0; j < 4; ++j) __hip_atomic_fetch_add(rowp + bj * HALF + n * 16 + j, acc[ai][bj][m][n][j], __ATOMIC_RELAXED, __HIP_MEMORY_SCOPE_AGENT); }
    }
};
struct OneUnit {
    int pm, pn;
    __device__ __forceinline__ bool next(int i, Unit& u) const { if (i != 0) return false; u.pm = pm; u.pn = pn; return true; }
    __device__ __forceinline__ void a_ready(const Unit&) const {}
    __device__ __forceinline__ void done(const Unit&) const {}
};
__device__ __forceinline__ float silu_f(float x) { return x * __builtin_amdgcn_rcpf(1.0f + __expf(-x)); }
struct EpiSwiGLU {
    static constexpr bool PERM = true, AFTER_DRAIN = false;
    bf16_t* O; int ldc;
    __device__ __forceinline__ void operator()(const f32x4 (&acc)[2][2][4][2], const Unit& u, int wr, int wc, int fr, int fq) const {
        const int row0 = u.pm * BM + wr * 64 + fr, col0 = u.pn * HALF + wc * 32 + 8 * fq;
#pragma unroll
        for (int ai = 0; ai < 2; ++ai)
#pragma unroll
            for (int m = 0; m < 4; ++m) { bf16_t* rowp = O + (size_t)(row0 + ai * HALF + m * 16) * ldc + col0;
                const f32x4 g0 = acc[ai][0][m][0], g1 = acc[ai][0][m][1], u0 = acc[ai][1][m][0], u1 = acc[ai][1][m][1];
                u32x4 w; w.x = cvt_pk_bf16(silu_f(g0[0]) * u0[0], silu_f(g0[1]) * u0[1]); w.y = cvt_pk_bf16(silu_f(g0[2]) * u0[2], silu_f(g0[3]) * u0[3]);
                w.z = cvt_pk_bf16(silu_f(g1[0]) * u1[0], silu_f(g1[1]) * u1[1]); w.w = cvt_pk_bf16(silu_f(g1[2]) * u1[2], silu_f(g1[3]) * u1[3]);
                *(u32x4*)rowp = w; }
    }
};
template <class Epi, class Sched, bool ALIGN_EPI = false, bool SP2 = false>
__device__ __forceinline__ void gemm_phase(PG8_LAS unsigned char* lds, const Gemm g, const Sched& S, const Epi& E) {
    const int tid = threadIdx.x, wid = __builtin_amdgcn_readfirstlane(tid >> 6), lane = tid & 63, wr = wid >> 2, wc = wid & 3, fr = lane & 15, fq = lane >> 4;
    const int K = g.ld, nt = g.K / BK;
    unsigned voffA[2], voffB[2];
#pragma unroll
    for (int i = 0; i < 2; ++i) { int R, C; stage_rc(tid * 16 + i * 8192, R, C); const int Rb = Epi::PERM ? ((R & ~31) + perm32(R & 31)) : R;
        voffA[i] = (unsigned)(R * K + C) * 2u; voffB[i] = (unsigned)(Rb * K + C) * 2u; }
    const size_t kstep = (size_t)(BK * 2);
    const size_t hstep = (size_t)HALF * K * 2;
    const size_t tstep = 2 * hstep;
    const unsigned ldsw = (unsigned)wid * 1024u;
    const int aoff = lds_byte(wr * 64 + fr, fq * 8), boff = lds_byte(wc * 32 + fr, fq * 8);
#define PG8_SA(b, h) (((b) * 2 + (h)) * HTB)
#define PG8_SB(b, h) ((4 + (b) * 2 + (h)) * HTB)
#define PG8_STAGE(bufoff, gbase, voff) do { _Pragma("unroll") for (int _i = 0; _i < 2; ++_i) \
        __builtin_amdgcn_global_load_lds((const unsigned*)((const char*)(gbase) + (voff)[_i]), (PG8_LAS unsigned*)(lds + (bufoff) + ldsw + _i * 8192), 16, 0, 0); } while (0)
#define PG8_LDA(dst, b, h) do { _Pragma("unroll") for (int m = 0; m < 4; ++m) _Pragma("unroll") for (int k = 0; k < 2; ++k) dst[m][k] = *(const PG8_LAS bf16x8*)(lds + PG8_SA(b, h) + aoff + m * 2048 + k * 1024); } while (0)
#define PG8_LDB(dst, b, h) do { _Pragma("unroll") for (int n = 0; n < 2; ++n) _Pragma("unroll") for (int k = 0; k < 2; ++k) dst[n][k] = *(const PG8_LAS bf16x8*)(lds + PG8_SB(b, h) + boff + n * 2048 + k * 1024); } while (0)
#define PG8_MMA(ai, bj, At, Bt) do { __builtin_amdgcn_s_setprio(1); _Pragma("unroll") for (int m = 0; m < 4; ++m) _Pragma("unroll") for (int n = 0; n < 2; ++n) _Pragma("unroll") for (int k = 0; k < 2; ++k) \
        acc[ai][bj][m][n] = __builtin_amdgcn_mfma_f32_16x16x32_bf16(Bt[n][k], At[m][k], acc[ai][bj][m][n], 0, 0, 0); __builtin_amdgcn_s_setprio(0); } while (0)
#define PG8_WAIT_V(n) asm volatile("s_waitcnt vmcnt(" #n ")" ::: "memory")
#define PG8_WAIT_L(n) asm volatile("s_waitcnt lgkmcnt(" #n ")" ::: "memory")
#define PG8_BAR __builtin_amdgcn_s_barrier()
#define PG8_SCHED __builtin_amdgcn_sched_barrier(0)
    Unit cur, nxt; int ui = 0;
    if (!S.next(0, cur)) return;
    f32x4 acc[2][2][4][2];
#pragma unroll
    for (int a = 0; a < 2; ++a)
#pragma unroll
        for (int b = 0; b < 2; ++b)
#pragma unroll
            for (int m = 0; m < 4; ++m)
#pragma unroll
                for (int n = 0; n < 2; ++n) acc[a][b][m][n] = (f32x4){0.f, 0.f, 0.f, 0.f};
    bf16x8 At[4][2], B0[2][2], B1[2][2];
    const char* cA = (const char*)g.A + (size_t)cur.pm * tstep; const char* cB = (const char*)g.Bt + (size_t)cur.pn * tstep;
    S.a_ready(cur);
    if constexpr (SP2) {
        PG8_STAGE(PG8_SB(0, 0), cB, voffB); PG8_STAGE(PG8_SB(0, 1), cB + hstep, voffB); PG8_STAGE(PG8_SA(0, 0), cA, voffA); PG8_STAGE(PG8_SA(0, 1), cA + hstep, voffA);
        if (wr == 1) PG8_BAR;
        PG8_WAIT_V(2); PG8_BAR;
        PG8_STAGE(PG8_SB(1, 0), cB + kstep, voffB); PG8_STAGE(PG8_SA(1, 0), cA + kstep, voffA); PG8_STAGE(PG8_SB(1, 1), cB + hstep + kstep, voffB);
        PG8_WAIT_V(6); PG8_BAR;
    } else {
        PG8_STAGE(PG8_SB(0, 0), cB, voffB); PG8_STAGE(PG8_SA(0, 0), cA, voffA); PG8_STAGE(PG8_SB(0, 1), cB + hstep, voffB); PG8_STAGE(PG8_SA(0, 1), cA + hstep, voffA);
        if (wr == 1) PG8_BAR;
        PG8_WAIT_V(4); PG8_BAR;
        PG8_STAGE(PG8_SB(1, 0), cB + kstep, voffB); PG8_STAGE(PG8_SA(1, 0), cA + kstep, voffA); PG8_STAGE(PG8_SB(1, 1), cB + hstep + kstep, voffB);
        PG8_WAIT_V(6); PG8_BAR;
    }
    for (;;) {
        const bool has_next = S.next(ui + 1, nxt);
        const char* nA = has_next ? (const char*)g.A + (size_t)nxt.pm * tstep : cA; const char* nB = has_next ? (const char*)g.Bt + (size_t)nxt.pn * tstep : cB;
        for (int t = 0; t < nt; t += 2) {
            const bool last = (t == nt - 2);
            const char* a1 = cA + (size_t)(t + 1) * kstep;
            const char* a2 = last ? nA : cA + (size_t)(t + 2) * kstep; const char* b2 = last ? nB : cB + (size_t)(t + 2) * kstep;
            const char* a3 = a2 + kstep; const char* b3 = b2 + kstep;
            if (last && has_next) S.a_ready(nxt);
            if constexpr (SP2) {
            PG8_LDB(B0, 0, 0); PG8_LDB(B1, 0, 1); PG8_SCHED; PG8_LDA(At, 0, 0); PG8_STAGE(PG8_SA(1, 1), a1 + hstep, voffA);
            PG8_WAIT_V(8); PG8_WAIT_L(0); PG8_BAR; PG8_MMA(0, 0, At, B0); PG8_MMA(0, 1, At, B1); PG8_BAR; PG8_SCHED;
            PG8_LDA(At, 0, 1); PG8_STAGE(PG8_SB(0, 0), b2, voffB); PG8_STAGE(PG8_SB(0, 1), b2 + hstep, voffB); PG8_STAGE(PG8_SA(0, 0), a2, voffA);
            PG8_WAIT_V(8); PG8_WAIT_L(0); PG8_BAR; PG8_MMA(1, 0, At, B0); PG8_MMA(1, 1, At, B1); PG8_BAR; PG8_SCHED;
            PG8_LDB(B0, 1, 0); PG8_LDB(B1, 1, 1); PG8_SCHED; PG8_LDA(At, 1, 0); PG8_STAGE(PG8_SA(0, 1), a2 + hstep, voffA);
            PG8_WAIT_V(8); PG8_WAIT_L(0); PG8_BAR; PG8_MMA(0, 0, At, B0); PG8_MMA(0, 1, At, B1); PG8_BAR; PG8_SCHED;
            PG8_LDA(At, 1, 1); PG8_STAGE(PG8_SB(1, 0), b3, voffB); PG8_STAGE(PG8_SB(1, 1), b3 + hstep, voffB); PG8_STAGE(PG8_SA(1, 0), a3, voffA);
            PG8_WAIT_V(8); PG8_WAIT_L(0); PG8_BAR; PG8_MMA(1, 0, At, B0); PG8_MMA(1, 1, At, B1); PG8_BAR; PG8_SCHED;
            } else {
            PG8_LDB(B0, 0, 0); PG8_SCHED; PG8_LDA(At, 0, 0); PG8_STAGE(PG8_SA(1, 1), a1 + hstep, voffA);
            PG8_WAIT_L(8); PG8_BAR; PG8_WAIT_L(0); PG8_MMA(0, 0, At, B0); PG8_BAR; PG8_SCHED;
            PG8_LDB(B1, 0, 1); PG8_STAGE(PG8_SB(0, 0), b2, voffB);
            PG8_BAR; PG8_WAIT_L(0); PG8_MMA(0, 1, At, B1); PG8_BAR;
            PG8_LDA(At, 0, 1); PG8_STAGE(PG8_SA(0, 0), a2, voffA);
            PG8_BAR; PG8_WAIT_L(0); PG8_MMA(1, 0, At, B0); PG8_BAR; PG8_SCHED;
            PG8_STAGE(PG8_SB(0, 1), b2 + hstep, voffB);
            PG8_WAIT_V(6); PG8_BAR; PG8_MMA(1, 1, At, B1); PG8_BAR;
            PG8_LDB(B0, 1, 0); PG8_SCHED; PG8_LDA(At, 1, 0); PG8_STAGE(PG8_SA(0, 1), a2 + hstep, voffA);
            PG8_WAIT_L(8); PG8_BAR; PG8_WAIT_L(0); PG8_MMA(0, 0, At, B0); PG8_BAR; PG8_SCHED;
            PG8_LDB(B1, 1, 1); PG8_STAGE(PG8_SB(1, 0), b3, voffB);
            PG8_BAR; PG8_WAIT_L(0); PG8_MMA(0, 1, At, B1); PG8_BAR;
            PG8_LDA(At, 1, 1); PG8_STAGE(PG8_SA(1, 0), a3, voffA);
            PG8_BAR; PG8_WAIT_L(0); PG8_MMA(1, 0, At, B0); PG8_BAR; PG8_SCHED;
            PG8_STAGE(PG8_SB(1, 1), b3 + hstep, voffB);
            PG8_WAIT_V(6); PG8_BAR; PG8_MMA(1, 1, At, B1); PG8_BAR;
            }
        }
        if constexpr (ALIGN_EPI) { if (wr == 0) PG8_BAR; }
        if constexpr (!Epi::AFTER_DRAIN) { E(acc, cur, wr, wc, fr, fq); S.done(cur); }
        if (!has_next) break;
#pragma unroll
        for (int a = 0; a < 2; ++a)
#pragma unroll
            for (int b = 0; b < 2; ++b)
#pragma unroll
                for (int m = 0; m < 4; ++m)
#pragma unroll
                    for (int n = 0; n < 2; ++n) acc[a][b][m][n] = (f32x4){0.f, 0.f, 0.f, 0.f};
        cur = nxt; cA = nA; cB = nB; ++ui;
        if constexpr (ALIGN_EPI) { if (wr == 1) PG8_BAR; }
    }
    PG8_WAIT_V(0);
    if constexpr (!ALIGN_EPI) { if (wr == 0) PG8_BAR; }
    PG8_BAR;
    if constexpr (Epi::AFTER_DRAIN) { E.fused(acc, cur, wr, wc, fr, fq, lds, wid, lane); S.done(cur); }
#undef PG8_SA
#undef PG8_SB
#undef PG8_STAGE
#undef PG8_LDA
#undef PG8_LDB
#undef PG8_MMA
#undef PG8_WAIT_V
#undef PG8_WAIT_L
#undef PG8_BAR
#undef PG8_SCHED
}
}
constexpr int NWAVES = 8;
constexpr int D = 4096, MP = 8192, MS = 256, M = MP + MS;
constexpr int TP = 2048, BP = 4, BS = 32, TS = 8, NSEQ = BP + BS;
constexpr int HA = 32, DKA = 128, CCONV = 12288, APROJ = 16448, NPROJ = 16640;
constexpr int HB = 64, KVH = 8, HD = 64, KVW = 512, NKVQ = 5120, WIN = 128, PAST = 16384;
constexpr int DFF = 11008, NGU = 22016;
constexpr float EPS = 1e-6f;
constexpr size_t O_Y = 0, O_SSM_P = 34603008, O_CONV_P = 36700160, O_WK_P = 36847616, O_WV_P = 37109760,
                 O_SSM_S = 37371904, O_CONV_S = 54149120, O_WK_S = 55328768, O_WV_S = 57425920, O_TOTAL = 59523072;
constexpr size_t WS_CTL = 0, CTL_ZERO_BYTES = 32768;
constexpr size_t WS_WIN  = 1u << 20;
constexpr size_t WS_WOUT = WS_WIN  + (size_t)NPROJ * D * 2;
constexpr size_t WS_WGU0 = WS_WOUT + (size_t)D * D * 2;
constexpr size_t WS_WGU1 = WS_WGU0 + (size_t)NGU * D * 2;
constexpr size_t WS_WDN0 = WS_WGU1 + (size_t)NGU * D * 2;
constexpr size_t WS_WDN1 = WS_WDN0 + (size_t)D * DFF * 2;
constexpr size_t WS_WKVQ = WS_WDN1 + (size_t)D * DFF * 2;
constexpr size_t WS_WO   = WS_WKVQ + (size_t)NKVQ * D * 2;
constexpr size_t WS_ABUF = WS_WO   + (size_t)D * D * 2;
constexpr size_t WS_PROJ = WS_ABUF + (size_t)M * D * 2;
constexpr size_t WS_QKVC = WS_PROJ + (size_t)M * NPROJ * 4;
constexpr size_t WS_GATE = WS_QKVC + (size_t)M * CCONV * 4;
constexpr size_t WS_O    = WS_GATE + (size_t)M * HA * 4 * 2;
constexpr size_t WS_KN   = WS_O    + (size_t)M * D * 4;
constexpr size_t WS_VN   = WS_KN   + (size_t)M * KVW * 4;
constexpr int NCHUNK = BP * HA * (TP / 64);
constexpr size_t WS_WM   = WS_VN   + (size_t)M * KVW * 4;
constexpr size_t WS_QG   = WS_WM   + (size_t)NCHUNK * 64 * 128 * 2;
constexpr size_t WS_KDT  = WS_QG   + (size_t)NCHUNK * 64 * 128 * 2;
constexpr size_t WS_U0   = WS_KDT  + (size_t)NCHUNK * 128 * 64 * 2;
constexpr size_t WS_QKM  = WS_U0   + (size_t)NCHUNK * 64 * 128 * 4;
constexpr size_t WS_EGL  = WS_QKM  + (size_t)NCHUNK * 64 * 64 * 2;
constexpr size_t WS_SLAB = WS_EGL  + (size_t)NCHUNK * 4;
constexpr size_t WS_ROPE = WS_SLAB + (size_t)16 * MS * D * 4;
constexpr size_t WS_END  = WS_ROPE + (size_t)M * 16 * 4;
constexpr size_t WS_HB16 = WS_PROJ + (size_t)400 * 1024 * 1024;
static_assert((size_t)400 * 1024 * 1024 >= (size_t)M * 16384 * 2 + (size_t)64 * 1024 * 1024 + (size_t)M * 64 * 4 && (size_t)400 * 1024 * 1024 + (size_t)MP * D * 2 <= (size_t)M * NPROJ * 4, "HB16 placement");
constexpr size_t WS_ACT  = WS_PROJ;
constexpr size_t WS_KVQ  = WS_QKVC;
constexpr size_t WS_QN   = WS_O;
static_assert((size_t)M * DFF * 2 <= (size_t)M * NPROJ * 4 && (size_t)M * NKVQ * 4 <= (size_t)M * CCONV * 4, "overlays");
constexpr int CW_BAR = 4096;
constexpr int RING_OFF = 0, RING_BYTES = 131072;
constexpr int PREP_HALF = 72704;
constexpr int LDSCTL_OFF = 146432, MISC_OFF = LDSCTL_OFF + 320;
static_assert(2 * PREP_HALF <= LDSCTL_OFF && RING_BYTES <= LDSCTL_OFF, "LDS map");
constexpr int LDS_BYTES = 147456;

#define GAS __attribute__((address_space(1)))
#define LAS __attribute__((address_space(3)))
typedef unsigned short bf16;
typedef unsigned v4u __attribute__((ext_vector_type(4)));
typedef unsigned v2u __attribute__((ext_vector_type(2)));
typedef float f32x4 __attribute__((ext_vector_type(4)));
typedef float f32x2 __attribute__((ext_vector_type(2)));
#define LDS_WAIT() asm volatile("s_waitcnt lgkmcnt(0)" ::: "memory")
#define VM_WAIT() asm volatile("s_waitcnt vmcnt(0)" ::: "memory")
#define LDS_BARRIER() do { asm volatile("s_waitcnt lgkmcnt(0)" ::: "memory"); __builtin_amdgcn_s_barrier(); asm volatile("" ::: "memory"); } while (0)
__device__ __forceinline__ unsigned f2bf(float f) { unsigned u = __builtin_bit_cast(unsigned, f); return (u + 0x7fffu + ((u >> 16) & 1u)) >> 16; }
typedef __bf16 bf16x2_t __attribute__((ext_vector_type(2)));
__device__ __forceinline__ unsigned pk2(float lo, float hi) { f32x2 v = {lo, hi}; bf16x2_t b = __builtin_convertvector(v, bf16x2_t); return __builtin_bit_cast(unsigned, b); }
__device__ __forceinline__ unsigned cvtpk_c(float lo, float hi) { f32x2 v = {lo, hi}; bf16x2_t b = __builtin_convertvector(v, bf16x2_t); return __builtin_bit_cast(unsigned, b); }
#define XB_TMO      128
#define XB_XCNT(j)  (256  + 64 * (j))
#define XB_XSUB(j)  (1280 + 64 * (j))
#define XB_XGEN(j)  (2304 + 64 * (j))
#define XB_TOP      3328
#define XB_TOPGEN   3392
#define XCD_BAR_WORDS 3456
static_assert((size_t)(CW_BAR + XCD_BAR_WORDS) * 4 <= CTL_ZERO_BYTES, "the per-launch memset covers every barrier word");
#define XB_SPIN_CAP (1u << 18)

__device__ __forceinline__ unsigned xb_ld(unsigned* p)              { return __hip_atomic_load(p, __ATOMIC_RELAXED, __HIP_MEMORY_SCOPE_AGENT); }
__device__ __forceinline__ unsigned xb_add(unsigned* p, unsigned v) { return __hip_atomic_fetch_add(p, v, __ATOMIC_RELAXED, __HIP_MEMORY_SCOPE_AGENT); }
__device__ __forceinline__ unsigned xb_xcc_id() { return (unsigned)__builtin_amdgcn_s_getreg((3 << 11) | 20) & 0xFu; }
#define XB_SPIN(cond, bar) do { unsigned _sp = 0; while (cond) { __builtin_amdgcn_s_sleep(1); \
    if ((++_sp & 255u) == 0u) { if (xb_ld(&(bar)[XB_TMO])) break; if (_sp > XB_SPIN_CAP) { atomicAdd(&(bar)[XB_TMO], 1u); break; } } } } while (0)

struct XcdBarrier {
    unsigned* bar; unsigned x;
    volatile LAS unsigned* st;
};

__device__ __forceinline__ XcdBarrier xcd_barrier_post(unsigned* bar, volatile LAS unsigned* st) {
    XcdBarrier b; b.bar = bar; b.x = xb_xcc_id(); b.st = st;
    if (threadIdx.x == 0) (void)xb_add(&bar[XB_XCNT(b.x)], 1u);
    return b;
}
__device__ __forceinline__ void xcd_barrier_complete(unsigned* bar, unsigned x, unsigned& nloc, unsigned& nx) {
    const unsigned G = gridDim.x * gridDim.y * gridDim.z;
    unsigned sum, cnt, mine, sp = 0u;
    for (;;) {
        sum = 0u; cnt = 0u; mine = 0u;
#pragma unroll
        for (unsigned j = 0; j < 16; ++j) { const unsigned c = xb_ld(&bar[XB_XCNT(j)]); sum += c; cnt += (c > 0u) ? 1u : 0u; mine = (j == x) ? c : mine; }
        if (sum == G) break;
        __builtin_amdgcn_s_sleep(1);
        if ((++sp & 255u) == 0u) { if (xb_ld(&bar[XB_TMO])) break; if (sp > XB_SPIN_CAP) { atomicAdd(&bar[XB_TMO], 1u); break; } }
    }
    nloc = mine > 0u ? mine : 1u; nx = cnt > 0u ? cnt : 1u;
}

__device__ __forceinline__ void xcd_barrier(const XcdBarrier& b) {
    asm volatile("s_waitcnt vmcnt(0)" ::: "memory");
    __syncthreads();
    if (threadIdx.x == 0) {
        unsigned* bar = b.bar;
        __builtin_amdgcn_s_waitcnt(0);
        unsigned nloc = b.st[0], nx = b.st[1];
        if (nloc == 0u) { xcd_barrier_complete(bar, b.x, nloc, nx); b.st[0] = nloc; b.st[1] = nx; }
        const unsigned old = xb_add(&bar[XB_XSUB(b.x)], 1u);
        const unsigned gen = old / nloc;
        if (old + 1u == (gen + 1u) * nloc) {
            __builtin_amdgcn_fence(__ATOMIC_RELEASE, "agent");
            asm volatile("s_waitcnt vmcnt(0)" ::: "memory");
            const unsigned og = xb_add(&bar[XB_TOP], 1u);
            const unsigned tg = og / nx;
            if (og + 1u == (tg + 1u) * nx) xb_add(&bar[XB_TOPGEN], 1u);
            else XB_SPIN(xb_ld(&bar[XB_TOPGEN]) == tg, bar);
            __builtin_amdgcn_fence(__ATOMIC_ACQUIRE, "agent");
            xb_add(&bar[XB_XGEN(b.x)], 1u);
            asm volatile("s_waitcnt vmcnt(0)" ::: "memory");
        } else {
            XB_SPIN(xb_ld(&bar[XB_XGEN(b.x)]) == gen, bar);
            __builtin_amdgcn_fence(__ATOMIC_ACQUIRE, "agent");
            asm volatile("s_waitcnt vmcnt(0)" ::: "memory");
        }
    }
    __syncthreads();
}
struct EpiProj {
    static constexpr bool PERM = true, AFTER_DRAIN = false;
    bf16* P; float* GR;
    __device__ __forceinline__ void operator()(const f32x4 (&acc)[2][2][4][2], const pg8::Unit& u, int wr, int wc, int fr, int fq) const {
        const int row0 = u.pm * 256 + wr * 64 + fr;
        if (u.pn < 64) { const int col0 = u.pn * 256 + wc * 32 + 8 * fq;
#pragma unroll
            for (int ai = 0; ai < 2; ++ai)
#pragma unroll
                for (int m = 0; m < 4; ++m) { bf16* rowp = P + (size_t)(row0 + ai * 128 + m * 16) * 16384 + col0;
#pragma unroll
                    for (int bj = 0; bj < 2; ++bj) { const f32x4 v0 = acc[ai][bj][m][0], v1 = acc[ai][bj][m][1];
                        v4u w; w.x = cvtpk_c(v0[0], v0[1]); w.y = cvtpk_c(v0[2], v0[3]); w.z = cvtpk_c(v1[0], v1[1]); w.w = cvtpk_c(v1[2], v1[3]); *(v4u*)(rowp + bj * 128) = w; } }
        } else if (wc < 2) {
#pragma unroll
            for (int ai = 0; ai < 2; ++ai)
#pragma unroll
                for (int m = 0; m < 4; ++m) { float* rowp = GR + (size_t)(row0 + ai * 128 + m * 16) * 64 + wc * 32 + 8 * fq;
                    *(f32x4*)rowp = acc[ai][0][m][0]; *(f32x4*)(rowp + 4) = acc[ai][0][m][1]; }
        }
    }
};
struct EpiSlab {
    static constexpr bool PERM = true, AFTER_DRAIN = false;
    bf16* S; int ldc;
    __device__ __forceinline__ void operator()(const f32x4 (&acc)[2][2][4][2], const pg8::Unit& u, int wr, int wc, int fr, int fq) const {
        const int row0 = u.pm * 256 + wr * 64 + fr, col0 = u.pn * 256 + wc * 32 + 8 * fq;
#pragma unroll
        for (int ai = 0; ai < 2; ++ai)
#pragma unroll
            for (int m = 0; m < 4; ++m) { bf16* rowp = S + (size_t)(row0 + ai * 128 + m * 16) * ldc + col0;
#pragma unroll
                for (int bj = 0; bj < 2; ++bj) { const f32x4 v0 = acc[ai][bj][m][0], v1 = acc[ai][bj][m][1];
                    v4u w; w.x = cvtpk_c(v0[0], v0[1]); w.y = cvtpk_c(v0[2], v0[3]); w.z = cvtpk_c(v1[0], v1[1]); w.w = cvtpk_c(v1[2], v1[3]); *(v4u*)(rowp + bj * 128) = w; } }
    }
};
__device__ __forceinline__ f32x4 bf4_to_f32(v2u w) { return (f32x4){__builtin_bit_cast(float, w.x << 16), __builtin_bit_cast(float, w.x & 0xffff0000u), __builtin_bit_cast(float, w.y << 16), __builtin_bit_cast(float, w.y & 0xffff0000u)}; }
struct EpiKVQ {
    static constexpr bool PERM = false, AFTER_DRAIN = false;
    float* KN; float* VN; bf16* QB; const float* rope; const float* k_norm; const float* q_norm; float* out;
    __device__ __forceinline__ void operator()(const f32x4 (&acc)[2][2][4][2], const pg8::Unit& u, int wr, int wc, int fr, int fq) const {
        const int s = 4 * u.pn + wc, row0 = u.pm * 256 + wr * 64 + fr;
        if (u.pn >= 2 && u.pn < 4) {
            const int kvh = s - 8;
#pragma unroll
            for (int ai = 0; ai < 2; ++ai)
#pragma unroll
                for (int m = 0; m < 4; ++m) { const int row = row0 + ai * 128 + m * 16; const bool samp = row >= MP; const int b = samp ? (row - MP) >> 3 : row >> 11, t = samp ? (row - MP) & 7 : row & 2047;
                    float* vp = VN + (size_t)row * KVW + kvh * 64 + 4 * fq;
                    float* wp = samp ? out + O_WV_S + ((size_t)b * WIN + (WIN - TS + t)) * KVW + kvh * 64 + 4 * fq : (t >= TP - WIN ? out + O_WV_P + ((size_t)b * WIN + (t - (TP - WIN))) * KVW + kvh * 64 + 4 * fq : nullptr);
#pragma unroll
                    for (int bj = 0; bj < 2; ++bj)
#pragma unroll
                        for (int n = 0; n < 2; ++n) { *(f32x4*)(vp + 32 * bj + 16 * n) = acc[ai][bj][m][n]; if (wp) *(f32x4*)(wp + 32 * bj + 16 * n) = acc[ai][bj][m][n]; } }
            return;
        }
        const bool isk = u.pn < 2; const float* nwp = isk ? k_norm : q_norm;
        f32x4 nw[2][2];
#pragma unroll
        for (int bj = 0; bj < 2; ++bj)
#pragma unroll
            for (int n = 0; n < 2; ++n) nw[bj][n] = *(const f32x4*)(nwp + 32 * bj + 16 * n + 4 * fq);
#pragma unroll
        for (int ai = 0; ai < 2; ++ai)
#pragma unroll
            for (int m = 0; m < 4; ++m) { const int row = row0 + ai * 128 + m * 16;
                float ss = 0.f;
#pragma unroll
                for (int bj = 0; bj < 2; ++bj)
#pragma unroll
                    for (int n = 0; n < 2; ++n) { const f32x4 v = acc[ai][bj][m][n]; ss += (v.x * v.x + v.y * v.y) + (v.z * v.z + v.w * v.w); }
                ss += __shfl_xor(ss, 16); ss += __shfl_xor(ss, 32);
                const float r = 1.0f / sqrtf(ss * (1.0f / 64.0f) + EPS);
                f32x4 y[2][2];
#pragma unroll
                for (int bj = 0; bj < 2; ++bj)
#pragma unroll
                    for (int n = 0; n < 2; ++n) y[bj][n] = acc[ai][bj][m][n] * r * nw[bj][n];
                const f32x4 cs = *(const f32x4*)(rope + (size_t)row * 16 + 4 * (fq & 1)), sn = *(const f32x4*)(rope + (size_t)row * 16 + 8 + 4 * (fq & 1));
                f32x4 p; p.x = __shfl_xor(y[0][0].x, 32); p.y = __shfl_xor(y[0][0].y, 32); p.z = __shfl_xor(y[0][0].z, 32); p.w = __shfl_xor(y[0][0].w, 32);
                y[0][0] = (fq < 2) ? y[0][0] * cs - p * sn : y[0][0] * cs + p * sn;
                if (isk) { const bool samp = row >= MP; const int b = samp ? (row - MP) >> 3 : row >> 11, t = samp ? (row - MP) & 7 : row & 2047;
                    float* kp = KN + (size_t)row * KVW + s * 64 + 4 * fq;
                    float* wp = samp ? out + O_WK_S + ((size_t)b * WIN + (WIN - TS + t)) * KVW + s * 64 + 4 * fq : (t >= TP - WIN ? out + O_WK_P + ((size_t)b * WIN + (t - (TP - WIN))) * KVW + s * 64 + 4 * fq : nullptr);
#pragma unroll
                    for (int bj = 0; bj < 2; ++bj)
#pragma unroll
                        for (int n = 0; n < 2; ++n) { *(f32x4*)(kp + 32 * bj + 16 * n) = y[bj][n]; if (wp) *(f32x4*)(wp + 32 * bj + 16 * n) = y[bj][n]; }
                } else { bf16* qp = QB + (size_t)row * D + (s - 16) * 64 + 4 * fq;
#pragma unroll
                    for (int bj = 0; bj < 2; ++bj)
#pragma unroll
                        for (int n = 0; n < 2; ++n) { const f32x4 z = y[bj][n] * 0.125f; v2u w; w.x = cvtpk_c(z.x, z.y); w.y = cvtpk_c(z.z, z.w); *(v2u*)(qp + 32 * bj + 16 * n) = w; } }
            }
    }
};

struct Args {
    const float *xp, *xs, *state_ssm, *state_conv, *cache_k, *cache_v, *norm_mix, *norm_ffn, *a_w_in, *a_conv_w, *a_log, *a_dt_bias, *a_o_norm, *a_w_out,
                *kv_norm, *w_kv, *k_norm, *b_w_q, *b_q_norm, *b_sinks, *b_w_o, *ffn_w_gu, *ffn_w_down;
    float* out; unsigned char* ws; int ph_lo, ph_hi;
};
static_assert(sizeof(Args) == 25 * 8 + 8, "Args has no padding");

__device__ __forceinline__ float wave_sum(float v) {
#pragma unroll
    for (int o = 1; o < 64; o <<= 1) v += __shfl_xor(v, o);
    return v;
}
__device__ __forceinline__ float silu_acc(float x) { return x / (1.0f + expf(-x)); }

__device__ __forceinline__ void tr_item(const float* __restrict__ src, int ldsrc, int c0, const float* __restrict__ gain, bf16* __restrict__ dst, int K, int r0, int k0, LAS float* scr, int lane) {
#pragma unroll 8
    for (int i = 0; i < 32; ++i) { const int kk = 2 * i + (lane >> 5); float v = src[(size_t)(k0 + kk) * ldsrc + c0 + (lane & 31)]; if (gain) v *= gain[k0 + kk]; scr[kk * 33 + (lane & 31)] = v; }
    LDS_WAIT(); asm volatile("" ::: "memory");
    const int c = lane & 7;
#pragma unroll
    for (int j = 0; j < 4; ++j) { const int n = (lane >> 3) + 8 * j; const LAS float* s = scr + (8 * c) * 33 + n;
        v4u o; o.x = pk2(s[0 * 33], s[1 * 33]); o.y = pk2(s[2 * 33], s[3 * 33]); o.z = pk2(s[4 * 33], s[5 * 33]); o.w = pk2(s[6 * 33], s[7 * 33]);
        *(v4u*)(dst + (size_t)(r0 + n) * K + k0 + 8 * c) = o; }
    LDS_WAIT(); asm volatile("" ::: "memory");
}
__device__ __forceinline__ void rms_gain_load(const float* __restrict__ gain, f32x4 (&g)[16], int lane) {
#pragma unroll
    for (int j = 0; j < 16; ++j) g[j] = gain ? ((const f32x4*)gain)[lane + 64 * j] : (f32x4){1.f, 1.f, 1.f, 1.f};
}
__device__ __forceinline__ void rms_row_bf16(const float* __restrict__ xr, const f32x4 (&g)[16], bf16* __restrict__ orow, int lane) {
    const f32x4* p = (const f32x4*)xr + lane; f32x4 v[16]; float s = 0.f;
#pragma unroll
    for (int j = 0; j < 16; ++j) { v[j] = p[64 * j]; s += (v[j].x * v[j].x + v[j].y * v[j].y) + (v[j].z * v[j].z + v[j].w * v[j].w); }
    const float rstd = 1.0f / sqrtf(wave_sum(s) * (1.0f / D) + EPS);
    v2u* o8 = (v2u*)orow + lane;
#pragma unroll
    for (int j = 0; j < 16; ++j) { const f32x4 y = v[j] * rstd * g[j];
        v2u w; w.x = pk2(y.x, y.y); w.y = pk2(y.z, y.w); o8[64 * j] = w; }
}
__device__ __forceinline__ void rms_gain_load8(const float* __restrict__ gain, f32x4 (&g)[16], int lane) {
#pragma unroll
    for (int j = 0; j < 8; ++j) { g[2 * j] = gain ? ((const f32x4*)gain)[2 * (lane + 64 * j)] : (f32x4){1.f, 1.f, 1.f, 1.f}; g[2 * j + 1] = gain ? ((const f32x4*)gain)[2 * (lane + 64 * j) + 1] : (f32x4){1.f, 1.f, 1.f, 1.f}; }
}
__device__ __forceinline__ void rms_row_from_bf16(const bf16* __restrict__ xr, const f32x4 (&g)[16], bf16* __restrict__ orow, int lane) {
    const v4u* p = (const v4u*)xr + lane; v4u r[8]; float s = 0.f;
#pragma unroll
    for (int j = 0; j < 8; ++j) r[j] = p[64 * j];
#pragma unroll
    for (int j = 0; j < 8; ++j) { const f32x4 a0 = bf4_to_f32((v2u){r[j].x, r[j].y}), a1 = bf4_to_f32((v2u){r[j].z, r[j].w});
        s += ((a0.x * a0.x + a0.y * a0.y) + (a0.z * a0.z + a0.w * a0.w)) + ((a1.x * a1.x + a1.y * a1.y) + (a1.z * a1.z + a1.w * a1.w)); }
    const float rstd = 1.0f / sqrtf(wave_sum(s) * (1.0f / D) + EPS);
    v4u* o8 = (v4u*)orow + lane;
#pragma unroll
    for (int j = 0; j < 8; ++j) { const f32x4 a0 = bf4_to_f32((v2u){r[j].x, r[j].y}), a1 = bf4_to_f32((v2u){r[j].z, r[j].w});
        const f32x4 y0 = a0 * rstd * g[2 * j], y1 = a1 * rstd * g[2 * j + 1];
        v4u w; w.x = pk2(y0.x, y0.y); w.y = pk2(y0.z, y0.w); w.z = pk2(y1.x, y1.y); w.w = pk2(y1.z, y1.w); o8[64 * j] = w; }
}
__device__ __forceinline__ void norm_phase(float* __restrict__ H, const bf16* __restrict__ Hb, const float* __restrict__ gain, bf16* __restrict__ A, const bf16* __restrict__ slab, LAS float* red, int G, int gw, int NGW, int lane, int wave) {
    { f32x4 gv[16]; rms_gain_load8(gain, gv, lane);
      for (int m = gw; m < MP; m += NGW) rms_row_from_bf16(Hb + (size_t)m * D, gv, A + (size_t)m * D, lane); }
    for (int r = blockIdx.x; r < MS; r += G) {
        const size_t ro = (size_t)(MP + r) * D + 512 * wave + 4 * lane;
        f32x4 v0 = *(const f32x4*)(H + ro), v1 = *(const f32x4*)(H + ro + 256);
        f32x4 p0[16], p1[16];
#pragma unroll
        for (int sp = 0; sp < 16; ++sp) { const bf16* q = slab + ((size_t)sp * MS + r) * D + 512 * wave + 4 * lane; p0[sp] = bf4_to_f32(*(const v2u*)q); p1[sp] = bf4_to_f32(*(const v2u*)(q + 256)); }
#pragma unroll
        for (int sp = 0; sp < 16; ++sp) { v0 += p0[sp]; v1 += p1[sp]; }
        *(f32x4*)(H + ro) = v0; *(f32x4*)(H + ro + 256) = v1;
        float s = wave_sum((v0.x * v0.x + v0.y * v0.y) + (v0.z * v0.z + v0.w * v0.w) + (v1.x * v1.x + v1.y * v1.y) + (v1.z * v1.z + v1.w * v1.w));
        __syncthreads();
        if (lane == 0) red[wave] = s;
        __syncthreads();
        s = ((red[0] + red[1]) + (red[2] + red[3])) + ((red[4] + red[5]) + (red[6] + red[7]));
        const float rstd = 1.0f / sqrtf(s * (1.0f / D) + EPS);
        const f32x4 g0 = gain ? *(const f32x4*)(gain + 512 * wave + 4 * lane) : (f32x4){1.f, 1.f, 1.f, 1.f}, g1 = gain ? *(const f32x4*)(gain + 512 * wave + 4 * lane + 256) : (f32x4){1.f, 1.f, 1.f, 1.f};
        const f32x4 y0 = v0 * rstd * g0, y1 = v1 * rstd * g1;
        v2u w0, w1; w0.x = pk2(y0.x, y0.y); w0.y = pk2(y0.z, y0.w); w1.x = pk2(y1.x, y1.y); w1.y = pk2(y1.z, y1.w);
        *(v2u*)(A + ro) = w0; *(v2u*)(A + ro + 256) = w1;
    }
}

constexpr int CV_KB = D / 64;
constexpr int CV_IN = CV_KB * (APROJ / 32), CV_OUT = CV_KB * (D / 32), CV_GU = CV_KB * (NGU / 32), CV_DN = (DFF / 64) * (D / 32), CV_KVQ = CV_KB * (NKVQ / 32), CV_O = CV_KB * (D / 32);
constexpr int CV_E_IN = CV_IN, CV_E_OUT = CV_E_IN + CV_OUT, CV_E_GU0 = CV_E_OUT + CV_GU, CV_E_DN0 = CV_E_GU0 + CV_DN, CV_E_KVQ = CV_E_DN0 + CV_KVQ, CV_E_O = CV_E_KVQ + CV_O, CV_E_GU1 = CV_E_O + CV_GU, CV_E_DN1 = CV_E_GU1 + CV_DN;
constexpr int LEFT_P1 = (M / 256) * (NPROJ / 256) % 256, LEFT_GU = (M / 256) * (NGU / 256) % 256, LEFT_KVQ = (M / 256) * (NKVQ / 256) % 256;
#ifndef CV_PACE
#define CV_PACE 0
#endif
#ifndef CV_N1
#define CV_N1 22
#endif
#ifndef CV_N7
#define CV_N7 22
#endif
#ifndef CV_N10
#define CV_N10 24
#endif
constexpr int CV_N12 = 2, ATT_UNITS_PER_WG = 5;
constexpr int CV_CAP1 = (256 - LEFT_P1) * NWAVES * CV_N1, CV_CAP7 = (256 - LEFT_GU) * NWAVES * CV_N7, CV_CAP10 = (256 - LEFT_KVQ) * NWAVES * CV_N10, CV_CAP12 = ATT_UNITS_PER_WG * CV_N12 * 256 * NWAVES;
constexpr int cv_max(int x, int y) { return x > y ? x : y; }
constexpr int CV_P0_END = cv_max(cv_max(CV_E_IN, CV_E_GU0 - CV_CAP1), cv_max(CV_E_KVQ - CV_CAP1 - CV_CAP7, CV_E_GU1 - CV_CAP1 - CV_CAP7 - CV_CAP10 - CV_CAP12));
constexpr int CV_P1_END = CV_P0_END + CV_CAP1, CV_P7_END = CV_P1_END + CV_CAP7, CV_P10_END = CV_P7_END + CV_CAP10, CV_P12_END = CV_P10_END + CV_CAP12;
static_assert(CV_P0_END >= CV_E_IN && CV_P1_END >= CV_E_GU0 && CV_P7_END >= CV_E_KVQ && CV_P12_END >= CV_E_GU1 && CV_P12_END <= CV_E_DN1, "conversion schedule: every copy is complete a barrier ahead of its GEMM");
struct CvItem { const float* src; const float* gain; bf16* dst; int ldsrc, c0, K, r0, k0; };
__device__ __forceinline__ CvItem cv_decode(const Args& a, unsigned char* ws, int it) {
    CvItem q; q.gain = nullptr; q.K = D; int r = it;
    if (r < CV_E_IN) { const int nblk = APROJ / 32, kb = r / nblk, nb = r % nblk; q.src = a.a_w_in; q.ldsrc = APROJ; q.c0 = 32 * nb; q.dst = (bf16*)(ws + WS_WIN); q.r0 = 32 * nb; q.k0 = 64 * kb; }
    else if (r < CV_E_OUT) { r -= CV_E_IN; const int nblk = D / 32, kb = r / nblk, nb = r % nblk; q.src = a.a_w_out; q.ldsrc = D; q.c0 = 32 * nb; q.dst = (bf16*)(ws + WS_WOUT); q.r0 = 32 * nb; q.k0 = 64 * kb; }
    else if (r < CV_E_GU0 || (r >= CV_E_O && r < CV_E_GU1)) { const int l = r >= CV_E_O; r -= l ? CV_E_O : CV_E_OUT; const int nblk = NGU / 32, kb = r / nblk, nb = r % nblk; q.r0 = 32 * nb; q.k0 = 64 * kb;
        const int pn = q.r0 >> 8, within = q.r0 & 255; q.c0 = (within >> 7) * DFF + 128 * pn + (within & 127);
        q.src = a.ffn_w_gu + (size_t)l * D * NGU; q.ldsrc = NGU; q.dst = (bf16*)(ws + (l ? WS_WGU1 : WS_WGU0)); }
    else if (r < CV_E_DN0 || r >= CV_E_GU1) { const int l = r >= CV_E_GU1; r -= l ? CV_E_GU1 : CV_E_GU0; const int nblk = D / 32, kb = r / nblk, nb = r % nblk;
        q.src = a.ffn_w_down + (size_t)l * DFF * D; q.ldsrc = D; q.c0 = 32 * nb; q.dst = (bf16*)(ws + (l ? WS_WDN1 : WS_WDN0)); q.K = DFF; q.r0 = 32 * nb; q.k0 = 64 * kb; }
    else if (r < CV_E_KVQ) { r -= CV_E_DN0; const int nblk = NKVQ / 32, kb = r / nblk, nb = r % nblk; q.r0 = 32 * nb; q.k0 = 64 * kb;
        const int hs = 4 * (q.r0 >> 8) + ((q.r0 >> 5) & 3); q.c0 = 64 * hs + 32 * ((q.r0 >> 7) & 1); q.dst = (bf16*)(ws + WS_WKVQ);
        if (hs < 16) { q.src = a.w_kv; q.ldsrc = 2 * KVW; q.gain = a.kv_norm; } else { q.src = a.b_w_q; q.ldsrc = D; q.c0 -= 2 * KVW; q.gain = a.norm_mix + D; } }
    else { r -= CV_E_KVQ; const int nblk = D / 32, kb = r / nblk, nb = r % nblk; q.src = a.b_w_o; q.ldsrc = D; q.c0 = 32 * nb; q.dst = (bf16*)(ws + WS_WO); q.r0 = 32 * nb; q.k0 = 64 * kb; }
    return q;
}
__device__ __forceinline__ void cv_load(const CvItem& q, f32x4 (&v)[8], int lane) {
#pragma unroll
    for (int i = 0; i < 8; ++i) v[i] = __builtin_nontemporal_load((const f32x4*)(q.src + (size_t)(q.k0 + 8 * i + (lane >> 3)) * q.ldsrc + q.c0 + 4 * (lane & 7)));
}
__device__ __forceinline__ void cv_store(const CvItem& q, const f32x4 (&v)[8], LAS float* scr, int lane) {
#pragma unroll
    for (int i = 0; i < 8; ++i) { LAS float* w = scr + (8 * i + (lane >> 3)) * 33 + 4 * (lane & 7); w[0] = v[i].x; w[1] = v[i].y; w[2] = v[i].z; w[3] = v[i].w; }
    LDS_WAIT(); asm volatile("" ::: "memory");
    const int c = lane & 7;
    f32x4 ga = {1.f, 1.f, 1.f, 1.f}, gb = {1.f, 1.f, 1.f, 1.f}; if (q.gain) { ga = *(const f32x4*)(q.gain + q.k0 + 8 * c); gb = *(const f32x4*)(q.gain + q.k0 + 8 * c + 4); }
#pragma unroll
    for (int j = 0; j < 4; ++j) { const int n = (lane >> 3) + 8 * j; const LAS float* s = scr + (8 * c) * 33 + n;
        v4u o; o.x = pk2(s[0 * 33] * ga.x, s[1 * 33] * ga.y); o.y = pk2(s[2 * 33] * ga.z, s[3 * 33] * ga.w); o.z = pk2(s[4 * 33] * gb.x, s[5 * 33] * gb.y); o.w = pk2(s[6 * 33] * gb.z, s[7 * 33] * gb.w);
        *(v4u*)(q.dst + (size_t)(q.r0 + n) * q.K + q.k0 + 8 * c) = o; }
    LDS_WAIT(); asm volatile("" ::: "memory");
}
constexpr int CV_DEPTH = 4;
template <int PACE>
__device__ __forceinline__ void convert_range(const Args& a, unsigned char* ws, int lo, int hi, int worker, int nworkers, LAS float* scr, int lane) {
    int it = lo + worker; if (it >= hi) return;
    CvItem q[CV_DEPTH]; f32x4 v[CV_DEPTH][8];
#pragma unroll
    for (int d = 0; d < CV_DEPTH - 1; ++d) { const int id = it + d * nworkers; q[d] = cv_decode(a, ws, id < hi ? id : it); cv_load(q[d], v[d], lane); }
    for (;;) {
#pragma unroll
        for (int d = 0; d < CV_DEPTH; ++d) {
            const int sp = (d + CV_DEPTH - 1) % CV_DEPTH, ip = it + (CV_DEPTH - 1) * nworkers;
            q[sp] = cv_decode(a, ws, ip < hi ? ip : it); cv_load(q[sp], v[sp], lane);
            cv_store(q[d], v[d], scr, lane); if (PACE) __builtin_amdgcn_s_sleep(PACE);
            it += nworkers; if (it >= hi) return;
        }
    }
}

__global__ void __launch_bounds__(NWAVES * 64, 2) yoco_fwd(Args a) {
    extern __shared__ __attribute__((aligned(16))) unsigned char lds_raw[];
    LAS unsigned char* lds = (LAS unsigned char*)lds_raw;
    const int tid = threadIdx.x, lane = tid & 63, wave = __builtin_amdgcn_readfirstlane(tid >> 6);
    const int G = gridDim.x, gw = blockIdx.x * NWAVES + wave, NGW = G * NWAVES;
    unsigned char* ws = a.ws;
    unsigned* ctl = (unsigned*)(ws + WS_CTL);
    for (int u = tid; u < (LDS_BYTES - LDSCTL_OFF) / 4; u += NWAVES * 64) ((LAS unsigned*)(lds + LDSCTL_OFF))[u] = 0u;
    __syncthreads();
    volatile LAS unsigned* MISC = (volatile LAS unsigned*)(lds + MISC_OFF);
    XcdBarrier bar = xcd_barrier_post(ctl + CW_BAR, MISC + 8);
    const int lo = a.ph_lo, hi = a.ph_hi;
#define IN(k) (lo <= (k) && (k) < hi)
#define SEAM(k) do { if (IN(k) && IN((k) + 1)) xcd_barrier(bar); } while (0)

    bf16* W_in = (bf16*)(ws + WS_WIN); bf16* W_out = (bf16*)(ws + WS_WOUT); bf16* W_kvq = (bf16*)(ws + WS_WKVQ); bf16* W_o = (bf16*)(ws + WS_WO);
    bf16* ABUF = (bf16*)(ws + WS_ABUF); bf16* PROJB = (bf16*)(ws + WS_PROJ); float* GR = (float*)(ws + WS_PROJ + (size_t)M * 16384 * 2 + (size_t)64 * 1024 * 1024);    float* QKVC = (float*)(ws + WS_QKVC);
    float* GG = (float*)(ws + WS_GATE); float* BETA = GG + (size_t)M * HA; bf16* OB = (bf16*)(ws + WS_O);
    float* KN = (float*)(ws + WS_KN); float* VN = (float*)(ws + WS_VN); bf16* ACT = (bf16*)(ws + WS_ACT); float* KVQ = (float*)(ws + WS_KVQ); bf16* QB = (bf16*)(ws + WS_QN);
    bf16* WMb = (bf16*)(ws + WS_WM); bf16* QGb = (bf16*)(ws + WS_QG); bf16* KDTb = (bf16*)(ws + WS_KDT); bf16* U0c = (bf16*)(ws + WS_U0); bf16* QKMb = (bf16*)(ws + WS_QKM); float* EGLb = (float*)(ws + WS_EGL);
    bf16* SLAB = (bf16*)(ws + WS_SLAB); float* ROPE = (float*)(ws + WS_ROPE); bf16* HB16 = (bf16*)(ws + WS_HB16);
    float* Hres = a.out + O_Y;

    if (IN(0)) {
        LAS float* scr = (LAS float*)(lds + RING_OFF + wave * 16384);
        convert_range<0>(a, ws, 0, CV_P0_END, gw, NGW, scr, lane);
        { f32x4 gv[16]; rms_gain_load(a.norm_mix, gv, lane);
          for (int m = gw; m < M; m += NGW) rms_row_bf16(m < MP ? a.xp + (size_t)m * D : a.xs + (size_t)(m - MP) * D, gv, ABUF + (size_t)m * D, lane); }
        for (int idx = blockIdx.x * (NWAVES * 64) + tid; idx < M * 8; idx += G * NWAVES * 64) { const int m = idx >> 3, i = idx & 7; const int pos = m < MP ? (m & 2047) : PAST + ((m - MP) & 7);
            const double c2p = i == 0 ? 0.15915494309189535 : i == 1 ? 0.03086376340470123 : i == 2 ? 0.005985185712713705 : i == 3 ? 0.001160663641240061 :
                               i == 4 ? 0.00022507907903927653 : i == 5 ? 4.364795279280289e-05 : i == 6 ? 8.464330808241401e-06 : 1.6414262627950345e-06;
            const double turns = (double)pos * c2p; const float fr = (float)(turns - floor(turns));
            ROPE[(size_t)m * 16 + i] = __builtin_amdgcn_cosf(fr); ROPE[(size_t)m * 16 + 8 + i] = __builtin_amdgcn_sinf(fr); }
        for (int i = blockIdx.x * (NWAVES * 64) + tid; i < BS * (WIN - TS) * (KVW / 4); i += G * NWAVES * 64) {
            const int c4 = i % (KVW / 4), br = i / (KVW / 4), r = br % (WIN - TS), b = br / (WIN - TS);
            ((f32x4*)(a.out + O_WK_S + ((size_t)b * WIN + r) * KVW))[c4] = ((const f32x4*)(a.cache_k + ((size_t)b * WIN + r + TS) * KVW))[c4];
            ((f32x4*)(a.out + O_WV_S + ((size_t)b * WIN + r) * KVW))[c4] = ((const f32x4*)(a.cache_v + ((size_t)b * WIN + r + TS) * KVW))[c4];
        }
    }
    SEAM(0);
    if (IN(1)) { pg8::Gemm g{ABUF, W_in, M, NPROJ, D, D}; pg8::StaticOrder S; S.init(M, NPROJ, G, (int)blockIdx.x); EpiProj E{PROJB, GR};
        pg8::gemm_phase<EpiProj, pg8::StaticOrder, true, true>(lds + RING_OFF, g, S, E);
        if ((int)blockIdx.x >= LEFT_P1) convert_range<CV_PACE>(a, ws, CV_P0_END, CV_P1_END, ((int)blockIdx.x - LEFT_P1) * NWAVES + wave, (G - LEFT_P1) * NWAVES, (LAS float*)(lds + RING_OFF + wave * 16384), lane); }
    SEAM(1);
    if (IN(2)) {
        for (int wu = MP * HA + gw; wu < M * HA; wu += NGW) {
            const int m = wu >> 5, h = wu & 31, b = (m - MP) >> 3, t = (m - MP) & 7;
            unsigned pw[3][4]; f32x2 sv[3][4], wv[3][4];
#pragma unroll
            for (int part = 0; part < 3; ++part) { const int c = part * 4096 + h * 128 + 2 * lane;
#pragma unroll
                for (int j = 0; j < 4; ++j) { const int tt = t - j;
                    pw[part][j] = *(const unsigned*)(PROJB + (size_t)(tt >= 0 ? m - j : m) * 16384 + c);
                    sv[part][j] = *(const f32x2*)(a.state_conv + ((size_t)b * 3 + (tt < 0 ? 3 + tt : 0)) * CCONV + c);
                    wv[part][j] = *(const f32x2*)(a.a_conv_w + (size_t)(3 - j) * CCONV + c); } }
            const float braw = GR[(size_t)m * 64 + h], araw = GR[(size_t)m * 64 + 32 + h] + a.a_dt_bias[h], alog = a.a_log[h];
            f32x2 res[3];
#pragma unroll
            for (int part = 0; part < 3; ++part) { f32x2 acc = {0.f, 0.f};
#pragma unroll
                for (int j = 0; j < 4; ++j) { const f32x2 xv = (t - j >= 0) ? (f32x2){__builtin_bit_cast(float, pw[part][j] << 16), __builtin_bit_cast(float, pw[part][j] & 0xffff0000u)} : sv[part][j]; acc += xv * wv[part][j]; }
                res[part].x = silu_acc(acc.x); res[part].y = silu_acc(acc.y); }
            const float sq = wave_sum(res[0].x * res[0].x + res[0].y * res[0].y), sk = wave_sum(res[1].x * res[1].x + res[1].y * res[1].y);
            const float rq = (1.0f / sqrtf(sq + EPS)) * 0.08838834764831845f, rk = 1.0f / sqrtf(sk + EPS);
            float* qo = QKVC + (size_t)m * CCONV + h * 128 + 2 * lane;
            *(f32x2*)qo = res[0] * rq; *(f32x2*)(qo + 4096) = res[1] * rk; *(f32x2*)(qo + 8192) = res[2];
            if (lane == 0) { const float sp = fmaxf(araw, 0.f) + log1pf(expf(-fabsf(araw)));
                GG[(size_t)m * HA + h] = -expf(alog) * sp; BETA[(size_t)m * HA + h] = 1.0f / (1.0f + expf(-braw)); }
        }
        for (int i = blockIdx.x * (NWAVES * 64) + tid; i < NSEQ * 3 * (CCONV / 4); i += G * NWAVES * 64) {
            const int c4 = i % (CCONV / 4), sr = i / (CCONV / 4), r = sr % 3, s = sr / 3;
            const int m = s < BP ? s * TP + (TP - 3) + r : MP + (s - BP) * TS + (TS - 3) + r;
            float* dst = s < BP ? a.out + O_CONV_P + ((size_t)s * 3 + r) * CCONV : a.out + O_CONV_S + ((size_t)(s - BP) * 3 + r) * CCONV;
            ((f32x4*)dst)[c4] = bf4_to_f32(((const v2u*)(PROJB + (size_t)m * 16384))[c4]);
        }
    }
    if (IN(3)) {
        {
            const int hb = wave >> 2, wh = wave & 3, th_o = tid & 255, lr_o = lane & 15, lq_o = lane >> 4;
            LAS unsigned char* hl = lds + RING_OFF + hb * PREP_HALF;
            LAS bf16* Kb = (LAS bf16*)hl;
            LAS bf16* Vb = (LAS bf16*)(hl + 17408);
            LAS bf16* Qb = (LAS bf16*)(hl + 34816);
            LAS float* Am = (LAS float*)(hl + 52224);
            LAS float* gcs = (LAS float*)(hl + 69632);
            const int nrep = (NCHUNK + 2 * G - 1) / (2 * G);
            v2u xraw[3][11];
#define PREP_FETCH(rep_, P0_, P1_) do { const int cu_ = (rep_) * 2 * G + blockIdx.x * 2 + hb, ci_ = cu_ < NCHUNK ? cu_ : 0, n_ = ci_ & 31, h_ = (ci_ >> 5) & 31, b_ = ci_ >> 10; \
                const bf16* pb_ = PROJB + (size_t)(b_ * TP + n_ * 64 + 8 * (th_o >> 5)) * 16384 + h_ * 128 + 4 * (th_o & 31); const int t0_ = n_ * 64 + 8 * (th_o >> 5); \
                _Pragma("unroll") for (int part = P0_; part < P1_; ++part) _Pragma("unroll") for (int k = 0; k < 11; ++k) \
                    xraw[part][k] = (t0_ + k - 3 >= 0) ? *(const v2u*)(pb_ + part * 4096 + (ptrdiff_t)(k - 3) * 16384) : (v2u){0u, 0u}; } while (0)
            PREP_FETCH(0, 0, 1);
            for (int rep = 0; rep < nrep; ++rep) {
                int th = th_o, lr = lr_o, lq = lq_o; asm volatile("" : "+v"(th), "+v"(lr), "+v"(lq));
                const int c4 = th & 31, rg = th >> 5;
                const int cu = rep * 2 * G + blockIdx.x * 2 + hb; const bool act = cu < NCHUNK; const int ci = act ? cu : 0;
                const int n = ci & 31, h = (ci >> 5) & 31, b = ci >> 10, m0 = b * TP + n * 64;
                float braw = 0.f, araw = 0.f; if (wh == 0) { const size_t mr = (size_t)(m0 + lane) * 64; braw = GR[mr + h]; araw = GR[mr + 32 + h]; }
                f32x4 qreg[8];
                { PREP_FETCH(rep, 1, 3);
#pragma unroll
                  for (int part = 0; part < 3; ++part) {
                      const float* cw = a.a_conv_w + part * 4096 + h * 128 + 4 * c4;
                      const f32x4 w0 = *(const f32x4*)cw, w1 = *(const f32x4*)(cw + CCONV), w2 = *(const f32x4*)(cw + 2 * CCONV), w3 = *(const f32x4*)(cw + 3 * CCONV);
                      f32x4 x[11];
#pragma unroll
                      for (int k = 0; k < 11; ++k) x[k] = bf4_to_f32(xraw[part][k]);
                      LAS bf16* tile = part == 0 ? Qb : (part == 1 ? Kb : Vb);
                      f32x4 y[8]; float ss[8];
#pragma unroll
                      for (int k = 0; k < 8; ++k) { y[k] = x[k] * w0 + x[k + 1] * w1 + x[k + 2] * w2 + x[k + 3] * w3;
                          y[k].x = pg8::silu_f(y[k].x); y[k].y = pg8::silu_f(y[k].y); y[k].z = pg8::silu_f(y[k].z); y[k].w = pg8::silu_f(y[k].w);
                          ss[k] = (y[k].x * y[k].x + y[k].y * y[k].y) + (y[k].z * y[k].z + y[k].w * y[k].w); }
                      if (part < 2) {
#pragma unroll
                          for (int o = 1; o < 32; o <<= 1) { float t[8];
#pragma unroll
                              for (int k = 0; k < 8; ++k) t[k] = __shfl_xor(ss[k], o);
#pragma unroll
                              for (int k = 0; k < 8; ++k) ss[k] += t[k]; }
#pragma unroll
                          for (int k = 0; k < 8; ++k) y[k] = y[k] * ((1.0f / sqrtf(ss[k] + EPS)) * (part == 0 ? 0.08838834764831845f : 1.0f)); }
#pragma unroll
                      for (int k = 0; k < 8; ++k) { if (part == 0) qreg[k] = y[k];
                          v2u w; w.x = cvtpk_c(y[k].x, y[k].y); w.y = cvtpk_c(y[k].z, y[k].w); *(LAS v2u*)(tile + (8 * rg + k) * 136 + 4 * c4) = w; } } }
                if (wh == 0) { araw += a.a_dt_bias[h];
                    const float sp = fmaxf(araw, 0.f) + log1pf(expf(-fabsf(araw)));
                    float g = -expf(a.a_log[h]) * sp; const float bt = 1.0f / (1.0f + expf(-braw));
#pragma unroll
                    for (int o = 1; o < 64; o <<= 1) { const float tt = __shfl_up(g, o); if (lane >= o) g += tt; }
                    const float gl = __shfl(g, 63), eg = expf(g);
                    gcs[lane] = g; gcs[64 + lane] = bt * eg; gcs[128 + lane] = bt; gcs[192 + lane] = expf(gl - g); gcs[256 + lane] = eg; }
                LDS_BARRIER();
                if (act) {
#pragma unroll
                    for (int k = 0; k < 8; ++k) { const int i = 8 * rg + k; const f32x4 y = qreg[k] * gcs[256 + i]; v2u w; w.x = cvtpk_c(y.x, y.y); w.y = cvtpk_c(y.z, y.w);
                        *(v2u*)(QGb + (((size_t)ci * 4 + (i >> 4)) * 4 + (c4 >> 3)) * 512 + ((((c4 & 7) >> 1) * 16) + (i & 15)) * 8 + 4 * (c4 & 1)) = w; } }
                { pg8::bf16x8 bK[4], bQ[4];
#pragma unroll
                  for (int ks = 0; ks < 4; ++ks) { bK[ks] = *(const LAS pg8::bf16x8*)(Kb + (16 * wh + lr) * 136 + 32 * ks + 8 * lq); bQ[ks] = *(const LAS pg8::bf16x8*)(Qb + (16 * wh + lr) * 136 + 32 * ks + 8 * lq); }
                  const int i = 16 * wh + lr; const float gi = gcs[i], bi = gcs[128 + i];
#pragma unroll
                  for (int jt = 0; jt < 4; ++jt) {
                      f32x4 ck = {0.f, 0.f, 0.f, 0.f}, cq = {0.f, 0.f, 0.f, 0.f};
                      if (jt <= wh) {
#pragma unroll
                          for (int ks = 0; ks < 4; ++ks) { const pg8::bf16x8 aK = *(const LAS pg8::bf16x8*)(Kb + (16 * jt + lr) * 136 + 32 * ks + 8 * lq);
                              ck = __builtin_amdgcn_mfma_f32_16x16x32_bf16(aK, bK[ks], ck, 0, 0, 0); cq = __builtin_amdgcn_mfma_f32_16x16x32_bf16(aK, bQ[ks], cq, 0, 0, 0); } }
                      f32x4 av, qv;
#pragma unroll
                      for (int r = 0; r < 4; ++r) { const int j = 16 * jt + 4 * lq + r; const float dec = (i >= j) ? __expf(gi - gcs[j]) : 0.f;
                          av[r] = (i > j) ? ck[r] * dec * bi : 0.f; qv[r] = cq[r] * dec; }
                      *(LAS f32x4*)(Am + i * 68 + 16 * jt + 4 * lq) = av;
                      if (act) { v2u w; w.x = cvtpk_c(qv[0], qv[1]); w.y = cvtpk_c(qv[2], qv[3]); *(v2u*)(QKMb + (((size_t)ci * 4 + wh) * 2 + (jt >> 1)) * 512 + ((2 * (jt & 1) + (lq >> 1)) * 16 + lr) * 8 + 4 * (lq & 1)) = w; } } }
                float xr[64];
                { const LAS bf16* col = (wh < 2) ? Kb + th : Vb + (th - 128);
#pragma unroll
                  for (int i = 0; i < 64; ++i) xr[i] = __builtin_bit_cast(float, (unsigned)col[i * 136] << 16); }
                if (wh < 2) {
                    if (act) { bf16* kp = KDTb + ((size_t)ci * 8 + (th >> 4)) * 1024 + (th & 15) * 8;
#pragma unroll
                        for (int i8 = 0; i8 < 8; ++i8) { v4u w;
                            w.x = cvtpk_c(xr[8 * i8 + 0] * gcs[192 + 8 * i8 + 0], xr[8 * i8 + 1] * gcs[192 + 8 * i8 + 1]); w.y = cvtpk_c(xr[8 * i8 + 2] * gcs[192 + 8 * i8 + 2], xr[8 * i8 + 3] * gcs[192 + 8 * i8 + 3]);
                            w.z = cvtpk_c(xr[8 * i8 + 4] * gcs[192 + 8 * i8 + 4], xr[8 * i8 + 5] * gcs[192 + 8 * i8 + 5]); w.w = cvtpk_c(xr[8 * i8 + 6] * gcs[192 + 8 * i8 + 6], xr[8 * i8 + 7] * gcs[192 + 8 * i8 + 7]);
                            *(v4u*)(kp + (i8 >> 2) * 512 + (i8 & 3) * 128) = w; } }
#pragma unroll
                    for (int i = 0; i < 64; ++i) xr[i] *= gcs[64 + i];
                } else {
#pragma unroll
                    for (int i = 0; i < 64; ++i) xr[i] *= gcs[128 + i];
                }
                LDS_BARRIER();
                { LAS bf16* Xs = Kb; LAS bf16* Ab = (LAS bf16*)(hl + 34816 + 2048); LAS float* Dg = (LAS float*)(hl + 34816 + 2048 + 9216); LAS float* Cs = Am;
#pragma unroll
                  for (int k = 0; k < 4; ++k) { const int e4 = th + 256 * k, i = e4 >> 4, j4 = (e4 & 15) * 4; const f32x4 a4 = *(const LAS f32x4*)(Am + i * 68 + j4);
                      const bool below = (j4 >> 4) < (i >> 4); v2u w; w.x = below ? cvtpk_c(a4.x, a4.y) : 0u; w.y = below ? cvtpk_c(a4.z, a4.w) : 0u; *(LAS v2u*)(Ab + i * 72 + j4) = w;
                      if ((j4 >> 4) == (i >> 4)) *(LAS f32x4*)(Dg + ((i >> 4) * 16 + (i & 15)) * 20 + (j4 & 15)) = a4; }
#pragma unroll
                  for (int k = 0; k < 9; ++k) *(LAS v4u*)(Xs + 8 * (th + 256 * k)) = (v4u){0u, 0u, 0u, 0u};
                  LDS_BARRIER();
#pragma unroll
                  for (int bi = 0; bi < 4; ++bi) {
                      if (bi > 0) {
                          f32x4 cacc[4]; pg8::bf16x8 aA[2], bX[4][2];
#pragma unroll
                          for (int ks = 0; ks < (bi == 3 ? 2 : 1); ++ks) { aA[ks] = *(const LAS pg8::bf16x8*)(Ab + (16 * bi + lr) * 72 + 32 * ks + 8 * lq);
#pragma unroll
                              for (int t4 = 0; t4 < 4; ++t4) bX[t4][ks] = *(const LAS pg8::bf16x8*)(Xs + (16 * (4 * wh + t4) + lr) * 72 + 32 * ks + 8 * lq); }
                          __builtin_amdgcn_sched_barrier(0);
#pragma unroll
                          for (int t4 = 0; t4 < 4; ++t4) { cacc[t4] = (f32x4){0.f, 0.f, 0.f, 0.f};
#pragma unroll
                              for (int ks = 0; ks < (bi == 3 ? 2 : 1); ++ks) cacc[t4] = __builtin_amdgcn_mfma_f32_16x16x32_bf16(aA[ks], bX[t4][ks], cacc[t4], 0, 0, 0); }
#pragma unroll
                          for (int t4 = 0; t4 < 4; ++t4)
#pragma unroll
                              for (int r = 0; r < 4; ++r) Cs[(16 * (4 * wh + t4) + lr) * 17 + 4 * lq + r] = cacc[t4][r];
                          LDS_BARRIER();
#pragma unroll
                          for (int r = 0; r < 16; ++r) xr[16 * bi + r] -= Cs[th * 17 + r];
                      }
#pragma unroll
                      for (int row = 1; row < 16; ++row) { float t = xr[16 * bi + row];
#pragma unroll
                          for (int q = 0; q <= (row - 1) / 4; ++q) { const f32x4 d4 = *(const LAS f32x4*)(Dg + (bi * 16 + row) * 20 + 4 * q);
                              if (4 * q + 0 < row) t -= d4.x * xr[16 * bi + 4 * q + 0];
                              if (4 * q + 1 < row) t -= d4.y * xr[16 * bi + 4 * q + 1];
                              if (4 * q + 2 < row) t -= d4.z * xr[16 * bi + 4 * q + 2];
                              if (4 * q + 3 < row) t -= d4.w * xr[16 * bi + 4 * q + 3]; }
                          xr[16 * bi + row] = t; }
                      {
                          v4u x0, x1;
                          x0.x = cvtpk_c(xr[16 * bi + 0], xr[16 * bi + 1]); x0.y = cvtpk_c(xr[16 * bi + 2], xr[16 * bi + 3]); x0.z = cvtpk_c(xr[16 * bi + 4], xr[16 * bi + 5]); x0.w = cvtpk_c(xr[16 * bi + 6], xr[16 * bi + 7]);
                          x1.x = cvtpk_c(xr[16 * bi + 8], xr[16 * bi + 9]); x1.y = cvtpk_c(xr[16 * bi + 10], xr[16 * bi + 11]); x1.z = cvtpk_c(xr[16 * bi + 12], xr[16 * bi + 13]); x1.w = cvtpk_c(xr[16 * bi + 14], xr[16 * bi + 15]);
                          *(LAS v4u*)(Xs + th * 72 + 16 * bi) = x0; *(LAS v4u*)(Xs + th * 72 + 16 * bi + 8) = x1;
                          LDS_BARRIER(); } } }
                if (rep + 1 < nrep) PREP_FETCH(rep + 1, 0, 1);
                if (act) { const LAS bf16* Xs = Kb;
#pragma unroll
                    for (int k = 0; k < 4; ++k) { const int wks = 4 * k + (th >> 6), w_ = wks >> 2, ks = wks & 3, ls = th & 63, lrs = ls & 15, lqs = ls >> 4;
                        const LAS bf16* xp = Xs + (32 * ks + 8 * lqs) * 72 + 16 * w_ + lrs; v4u o;
                        o.x = ((unsigned)xp[0 * 72] | ((unsigned)xp[1 * 72] << 16)) ^ 0x80008000u; o.y = ((unsigned)xp[2 * 72] | ((unsigned)xp[3 * 72] << 16)) ^ 0x80008000u;
                        o.z = ((unsigned)xp[4 * 72] | ((unsigned)xp[5 * 72] << 16)) ^ 0x80008000u; o.w = ((unsigned)xp[6 * 72] | ((unsigned)xp[7 * 72] << 16)) ^ 0x80008000u;
                        *(v4u*)(WMb + (((size_t)ci * 4 + w_) * 4 + ks) * 512 + ls * 8) = o; }
#pragma unroll
                    for (int k = 0; k < 2; ++k) { const int slot = th + 256 * k, ls = slot & 63, ws_ = (slot >> 6) & 3, hs = slot >> 8, lrs = ls & 15, lqs = ls >> 4;
                        v2u t4[4];
#pragma unroll
                        for (int ct = 0; ct < 4; ++ct) t4[ct] = *(const LAS v2u*)(Xs + (128 + 64 * hs + 16 * ct + lrs) * 72 + 16 * ws_ + 4 * lqs);
                        v4u* up = (v4u*)(U0c + ((((size_t)ci * 2 + hs) * 4 + ws_) * 64 + ls) * 16);
                        v4u u0, u1; u0.x = t4[0].x; u0.y = t4[0].y; u0.z = t4[1].x; u0.w = t4[1].y; u1.x = t4[2].x; u1.y = t4[2].y; u1.z = t4[3].x; u1.w = t4[3].y; up[0] = u0; up[1] = u1; }
                    if (th == 0) EGLb[ci] = gcs[256 + 63];
                }
                LDS_BARRIER();
            }
        }
        xcd_barrier(bar);
        for (int un = gw; un < BS * HA * 8; un += NGW) {
            const int s = un / 256, h = (un >> 3) & 31, cg = un & 7;
            const int m0 = MP + s * TS;
            const int e = cg * 16 + (lane & 15), dg = lane >> 4;
            float hst[32];
            { const float* hp = a.state_ssm + (((size_t)s * HA + h) * DKA + dg * 32) * 128 + e;
#pragma unroll
              for (int i = 0; i < 32; ++i) hst[i] = hp[(size_t)i * 128]; }
            f32x4 kc[8], qc[8], kn[8], qn[8]; float vc, gc, bc, vn = 0.f, gn = 0.f, bn = 0.f;
            { const float* rp = QKVC + (size_t)m0 * CCONV + h * 128;
#pragma unroll
              for (int i = 0; i < 8; ++i) { qc[i] = *(const f32x4*)(rp + dg * 32 + 4 * i); kc[i] = *(const f32x4*)(rp + 4096 + dg * 32 + 4 * i); }
              vc = rp[8192 + e]; gc = GG[(size_t)m0 * HA + h]; bc = BETA[(size_t)m0 * HA + h]; }
#pragma unroll 1
            for (int t = 0; t < TS; ++t) {
                const int m = m0 + t;
                if (t + 1 < TS) { const float* rp = QKVC + (size_t)(m + 1) * CCONV + h * 128;
#pragma unroll
                    for (int i = 0; i < 8; ++i) { qn[i] = *(const f32x4*)(rp + dg * 32 + 4 * i); kn[i] = *(const f32x4*)(rp + 4096 + dg * 32 + 4 * i); }
                    vn = rp[8192 + e]; gn = GG[(size_t)(m + 1) * HA + h]; bn = BETA[(size_t)(m + 1) * HA + h]; }
                const float decay = expf(gc);
                float p0 = 0.f, p1 = 0.f, p2 = 0.f, p3 = 0.f;
#pragma unroll
                for (int i = 0; i < 8; ++i) { p0 += kc[i].x * hst[4 * i]; p1 += kc[i].y * hst[4 * i + 1]; p2 += kc[i].z * hst[4 * i + 2]; p3 += kc[i].w * hst[4 * i + 3]; }
                float kh = (p0 + p1) + (p2 + p3); kh += __shfl_xor(kh, 16); kh += __shfl_xor(kh, 32);
                const float u = bc * (vc - decay * kh);
                p0 = 0.f; p1 = 0.f; p2 = 0.f; p3 = 0.f;
#pragma unroll
                for (int i = 0; i < 8; ++i) {
                    hst[4 * i] = decay * hst[4 * i] + kc[i].x * u; hst[4 * i + 1] = decay * hst[4 * i + 1] + kc[i].y * u; hst[4 * i + 2] = decay * hst[4 * i + 2] + kc[i].z * u; hst[4 * i + 3] = decay * hst[4 * i + 3] + kc[i].w * u;
                    p0 += qc[i].x * hst[4 * i]; p1 += qc[i].y * hst[4 * i + 1]; p2 += qc[i].z * hst[4 * i + 2]; p3 += qc[i].w * hst[4 * i + 3]; }
                float o = (p0 + p1) + (p2 + p3); o += __shfl_xor(o, 16); o += __shfl_xor(o, 32);
                if (dg == 0) OB[(size_t)m * D + h * 128 + e] = (bf16)f2bf(o);
#pragma unroll
                for (int i = 0; i < 8; ++i) { kc[i] = kn[i]; qc[i] = qn[i]; }
                vc = vn; gc = gn; bc = bn;
            }
            float* hp = a.out + O_SSM_S + (((size_t)s * HA + h) * DKA + dg * 32) * 128 + e;
#pragma unroll
            for (int i = 0; i < 32; ++i) hp[(size_t)i * 128] = hst[i];
        }
        {
            LAS bf16* Ht = (LAS bf16*)(lds + RING_OFF);
            LAS bf16* Ut = (LAS bf16*)(lds + RING_OFF + 17408);
            const int lr = lane & 15, lq = lane >> 4, w = wave;
            for (int un = blockIdx.x; un < BP * HA * 2; un += G) {
                const int b = un >> 6, h = (un >> 1) & 31, e0 = 64 * (un & 1);
                __syncthreads();
                for (int i = tid; i < 64 * 136 / 2; i += NWAVES * 64) ((LAS unsigned*)Ht)[i] = 0u;
                f32x4 Hacc[4];
#pragma unroll
                for (int ct = 0; ct < 4; ++ct) Hacc[ct] = (f32x4){0.f, 0.f, 0.f, 0.f};
                __syncthreads();
                const size_t cb = ((size_t)(b * HA + h)) * 32;
                v4u AF[4], AKD[2], AX0, AX1, BF[4], BKD[2], BX0, BX1, CF[4], CKD[2], CX0, CX1; float AE, BE, CE;
#define SCAN_LOAD(S, ci) do { const size_t _ci = (ci); \
                    const bf16* _rf = (w < 4 ? WMb : QGb) + (_ci * 4 + (w & 3)) * 2048 + lane * 8; const int _fs = 512; \
                    _Pragma("unroll") for (int ks = 0; ks < 4; ++ks) S##F[ks] = *(const v4u*)(_rf + _fs * ks); \
                    const bf16* _rk = KDTb + (_ci * 8 + w) * 1024 + lane * 8; S##KD[0] = *(const v4u*)_rk; S##KD[1] = *(const v4u*)(_rk + 512); \
                    const bf16* _rx = (w < 4) ? U0c + (((_ci * 2 + (e0 >> 6)) * 4 + w) * 64 + lane) * 16 : QKMb + (_ci * 4 + (w - 4)) * 1024 + lane * 8; \
                    S##X0 = *(const v4u*)_rx; S##X1 = *(const v4u*)(_rx + (w < 4 ? 8 : 512)); S##E = EGLb[_ci]; } while (0)
#define BF2F_LO(u) __builtin_bit_cast(float, (u) << 16)
#define BF2F_HI(u) __builtin_bit_cast(float, (u) & 0xffff0000u)
#define SCAN_STEP(S, nn) do { const int n_ = (nn); f32x4 acc[4]; \
                    if (w < 4) { acc[0] = (f32x4){BF2F_LO(S##X0.x), BF2F_HI(S##X0.x), BF2F_LO(S##X0.y), BF2F_HI(S##X0.y)}; acc[1] = (f32x4){BF2F_LO(S##X0.z), BF2F_HI(S##X0.z), BF2F_LO(S##X0.w), BF2F_HI(S##X0.w)}; \
                                 acc[2] = (f32x4){BF2F_LO(S##X1.x), BF2F_HI(S##X1.x), BF2F_LO(S##X1.y), BF2F_HI(S##X1.y)}; acc[3] = (f32x4){BF2F_LO(S##X1.z), BF2F_HI(S##X1.z), BF2F_LO(S##X1.w), BF2F_HI(S##X1.w)}; } \
                    else { _Pragma("unroll") for (int ct = 0; ct < 4; ++ct) acc[ct] = (f32x4){0.f, 0.f, 0.f, 0.f}; } \
                    _Pragma("unroll") for (int c2 = 0; c2 < 2; ++c2) { pg8::bf16x8 bH[2][4]; \
                      _Pragma("unroll") for (int ct = 0; ct < 2; ++ct) _Pragma("unroll") for (int ks = 0; ks < 4; ++ks) bH[ct][ks] = *(const LAS pg8::bf16x8*)(Ht + (16 * (2 * c2 + ct) + lr) * 136 + 32 * ks + 8 * lq); \
                      __builtin_amdgcn_sched_barrier(0); \
                      _Pragma("unroll") for (int ks = 0; ks < 4; ++ks) _Pragma("unroll") for (int ct = 0; ct < 2; ++ct) \
                            acc[2 * c2 + ct] = __builtin_amdgcn_mfma_f32_16x16x32_bf16(__builtin_bit_cast(pg8::bf16x8, S##F[ks]), bH[ct][ks], acc[2 * c2 + ct], 0, 0, 0); \
                      __builtin_amdgcn_sched_barrier(0); } \
                    if (w < 4) { \
                        _Pragma("unroll") for (int ct = 0; ct < 4; ++ct) { v2u uw; uw.x = cvtpk_c(acc[ct][0], acc[ct][1]); uw.y = cvtpk_c(acc[ct][2], acc[ct][3]); \
                            *(LAS v2u*)(Ut + (16 * ct + lr) * 72 + 16 * w + 4 * lq) = uw; } } \
                    LDS_BARRIER(); \
                    const int m0 = b * TP + n_ * 64; \
                    pg8::bf16x8 bU[4][2]; \
                    _Pragma("unroll") for (int ct = 0; ct < 4; ++ct) _Pragma("unroll") for (int k2 = 0; k2 < 2; ++k2) bU[ct][k2] = *(const LAS pg8::bf16x8*)(Ut + (16 * ct + lr) * 72 + 32 * k2 + 8 * lq); \
                    __builtin_amdgcn_sched_barrier(0); \
                    _Pragma("unroll") for (int ct = 0; ct < 4; ++ct) { Hacc[ct] = Hacc[ct] * S##E; \
                        _Pragma("unroll") for (int k2 = 0; k2 < 2; ++k2) { \
                            Hacc[ct] = __builtin_amdgcn_mfma_f32_16x16x32_bf16(__builtin_bit_cast(pg8::bf16x8, S##KD[k2]), bU[ct][k2], Hacc[ct], 0, 0, 0); \
                            if (w >= 4) acc[ct] = __builtin_amdgcn_mfma_f32_16x16x32_bf16(__builtin_bit_cast(pg8::bf16x8, k2 ? S##X1 : S##X0), bU[ct][k2], acc[ct], 0, 0, 0); } \
                        v2u hw; hw.x = cvtpk_c(Hacc[ct][0], Hacc[ct][1]); hw.y = cvtpk_c(Hacc[ct][2], Hacc[ct][3]); \
                        *(LAS v2u*)(Ht + (16 * ct + lr) * 136 + 16 * w + 4 * lq) = hw; \
                        if (w >= 4) { \
                            const unsigned o01 = cvtpk_c(acc[ct][0], acc[ct][1]), o23 = cvtpk_c(acc[ct][2], acc[ct][3]); bf16* op = OB + (size_t)(m0 + 16 * (w - 4) + 4 * lq) * D + h * 128 + e0 + 16 * ct + lr; \
                            op[0] = (bf16)o01; op[D] = (bf16)(o01 >> 16); op[2 * D] = (bf16)o23; op[3 * D] = (bf16)(o23 >> 16); } } \
                    LDS_BARRIER(); \
                    if (n_ + 3 < 32) SCAN_LOAD(S, cb + n_ + 3); } while (0)
                SCAN_LOAD(A, cb); SCAN_LOAD(B, cb + 1); SCAN_LOAD(C, cb + 2);
                for (int n = 0; n < 30; n += 3) { SCAN_STEP(A, n); SCAN_STEP(B, n + 1); SCAN_STEP(C, n + 2); }
                SCAN_STEP(A, 30); SCAN_STEP(B, 31);
#undef SCAN_STEP
#undef SCAN_LOAD
#pragma unroll
                for (int ct = 0; ct < 4; ++ct)
#pragma unroll
                    for (int r = 0; r < 4; ++r) a.out[O_SSM_P + (((size_t)(b * HA + h)) * DKA + 16 * w + 4 * lq + r) * 128 + e0 + 16 * ct + lr] = Hacc[ct][r];
            }
            __syncthreads();
        }
    }
    SEAM(3);
    if (IN(4)) {
        { const int c = 4 * (lane & 31); const f32x4 w4 = *(const f32x4*)(a.a_o_norm + c);
          for (int wu0 = gw; wu0 < M * HA / 2; wu0 += 8 * NGW) {
              f32x4 o4[8]; v2u zr[8];
#pragma unroll
              for (int k = 0; k < 8; ++k) { const int wu = wu0 + k * NGW; if (wu < M * HA / 2) { const int mh = 2 * wu + (lane >> 5), m = mh >> 5, h = mh & 31;
                      o4[k] = bf4_to_f32(*(const v2u*)(OB + (size_t)m * D + h * 128 + c)); zr[k] = *(const v2u*)(PROJB + (size_t)m * 16384 + CCONV + h * 128 + c); } else { o4[k] = (f32x4){0.f, 0.f, 0.f, 0.f}; zr[k] = (v2u){0u, 0u}; } }
              float ss[8];
#pragma unroll
              for (int k = 0; k < 8; ++k) ss[k] = (o4[k].x * o4[k].x + o4[k].y * o4[k].y) + (o4[k].z * o4[k].z + o4[k].w * o4[k].w);
#pragma unroll
              for (int o = 1; o < 32; o <<= 1) { float t[8];
#pragma unroll
                  for (int k = 0; k < 8; ++k) t[k] = __shfl_xor(ss[k], o);
#pragma unroll
                  for (int k = 0; k < 8; ++k) ss[k] += t[k]; }
#pragma unroll
              for (int k = 0; k < 8; ++k) { const int wu = wu0 + k * NGW; if (wu < M * HA / 2) { const int mh = 2 * wu + (lane >> 5), m = mh >> 5, h = mh & 31;
                      const float r = __builtin_amdgcn_rsqf(ss[k] * (1.0f / 128.0f) + EPS); const f32x4 z4 = bf4_to_f32(zr[k]);
                      v2u ow; ow.x = pk2(o4[k].x * r * w4.x * pg8::silu_f(z4.x), o4[k].y * r * w4.y * pg8::silu_f(z4.y)); ow.y = pk2(o4[k].z * r * w4.z * pg8::silu_f(z4.z), o4[k].w * r * w4.w * pg8::silu_f(z4.w));
                      *(v2u*)(ABUF + (size_t)m * D + h * 128 + c) = ow; } } } }
        for (int i = blockIdx.x * (NWAVES * 64) + tid; i < MS * D / 4; i += G * NWAVES * 64) ((f32x4*)(Hres + (size_t)MP * D))[i] = ((const f32x4*)a.xs)[i];
    }
    SEAM(4);
#define GEMM_N4096(Aop, Wt, KK, INF_, OUTF_, BASEF) do { \
    { pg8::Gemm g{Aop, Wt, MP, D, KK, KK}; pg8::StaticOrder S; S.init(MP, D, G, (int)blockIdx.x); pg8::EpiResT<INF_, OUTF_> E{BASEF, Hres, HB16, D}; \
      pg8::gemm_phase<pg8::EpiResT<INF_, OUTF_>, pg8::StaticOrder, true, true>(lds + RING_OFF, g, S, E); } \
    { const int sp = 2 * ((int)blockIdx.x & 7) + (((int)blockIdx.x >> 3) & 1), pn = (int)blockIdx.x >> 4;     \
      const int k0 = (KK == D) ? 256 * sp : (sp < 6 ? 768 * sp : 4608 + 640 * (sp - 6)), kl = (KK == D) ? 256 : (sp < 6 ? 768 : 640); \
      pg8::Gemm g{Aop + (size_t)MP * KK + k0, Wt + k0, MS, D, kl, KK}; pg8::OneUnit S{0, pn}; EpiSlab E{SLAB + (size_t)sp * MS * D, D}; \
      pg8::gemm_phase<EpiSlab, pg8::OneUnit, false, true>(lds + RING_OFF, g, S, E); } } while (0)
    if (IN(5)) GEMM_N4096(ABUF, W_out, D, true, false, a.xp);
    SEAM(5);
    if (IN(6)) norm_phase(Hres, HB16, a.norm_ffn, ABUF, SLAB, (LAS float*)(lds + RING_OFF), G, gw, NGW, lane, wave);
    SEAM(6);
    if (IN(7)) { pg8::Gemm g{ABUF, (const bf16*)(ws + WS_WGU0), M, NGU, D, D}; pg8::StaticOrder S; S.init(M, NGU, G, (int)blockIdx.x); pg8::EpiSwiGLU E{ACT, DFF};
        pg8::gemm_phase<pg8::EpiSwiGLU, pg8::StaticOrder, true, true>(lds + RING_OFF, g, S, E);
        if ((int)blockIdx.x >= LEFT_GU) convert_range<CV_PACE>(a, ws, CV_P1_END, CV_P7_END, ((int)blockIdx.x - LEFT_GU) * NWAVES + wave, (G - LEFT_GU) * NWAVES, (LAS float*)(lds + RING_OFF + wave * 16384), lane); }
    SEAM(7);
    if (IN(8)) GEMM_N4096(ACT, (const bf16*)(ws + WS_WDN0), DFF, false, false, (const float*)nullptr);
    SEAM(8);
    if (IN(9)) norm_phase(Hres, HB16, nullptr, ABUF, SLAB, (LAS float*)(lds + RING_OFF), G, gw, NGW, lane, wave);
    SEAM(9);
    if (IN(10)) { pg8::Gemm g{ABUF, W_kvq, M, NKVQ, D, D}; pg8::StaticOrder S; S.init(M, NKVQ, G, (int)blockIdx.x); EpiKVQ E{KN, VN, QB, ROPE, a.k_norm, a.b_q_norm, a.out};
        pg8::gemm_phase<EpiKVQ, pg8::StaticOrder, true, true>(lds + RING_OFF, g, S, E);
        if ((int)blockIdx.x >= LEFT_KVQ) convert_range<CV_PACE>(a, ws, CV_P7_END, CV_P10_END, ((int)blockIdx.x - LEFT_KVQ) * NWAVES + wave, (G - LEFT_KVQ) * NWAVES, (LAS float*)(lds + RING_OFF + wave * 16384), lane); }
    SEAM(10);
    if (IN(12)) {
        LAS bf16* Kt = (LAS bf16*)(lds + RING_OFF);
        LAS bf16* Vt = (LAS bf16*)(lds + RING_OFF + 208 * 144);
        const int lr = lane & 15, lq = lane >> 4;
        constexpr int NU = BP * KVH * (TP / 64) + BS * KVH;
        static_assert(NU == ATT_UNITS_PER_WG * 256, "every workgroup runs the same number of attention units (the conversion items beside them are counted per unit)");
        LAS float* cscr = (LAS float*)(lds + RING_OFF + 65536 + wave * 8448); int cvk = 0;
        for (int un = blockIdx.x; un < NU; un += G) {
            bool samp; int b, kvh, q0;
            if (un < BP * KVH * (TP / 64)) { samp = false; b = un / (KVH * (TP / 64)); const int r = un % (KVH * (TP / 64)); kvh = r / (TP / 64); q0 = (r % (TP / 64)) * 64; }
            else { samp = true; const int r = un - BP * KVH * (TP / 64); b = r / KVH; kvh = r % KVH; q0 = WIN; }
            const int cvit = CV_P10_END + cvk * CV_N12 * NGW + gw; ++cvk;
            const CvItem cqa = cv_decode(a, ws, cvit); f32x4 cva[8]; cv_load(cqa, cva, lane);
            f32x4 kq[7], vq[7];
            auto tile_src = [&](const float* N, const float* cache, int kp, bool inr, bool& ok) -> const float* {
                const int kc = kp < 0 ? 0 : kp;
                const float* p = !samp ? N + ((size_t)(b * TP + kc)) * KVW : (kc < WIN ? cache + ((size_t)b * WIN + kc) * KVW : N + ((size_t)(MP + b * TS + (kc - WIN))) * KVW);
                ok = inr && (!samp ? (kp >= 0 && kp < TP) : (kp < WIN + TS));
                return (ok ? p : N) + kvh * 64; };
#pragma unroll
            for (int it = 0; it < 7; ++it) { const int i = tid + NWAVES * 64 * it; bool ok;
                { const int j = i >> 4, c4 = i & 15; const float* p = tile_src(KN, a.cache_k, q0 - WIN + j, i < 208 * 16, ok); kq[it] = ((const f32x4*)p)[c4]; }
                { const int c4 = i / 208, j = i - c4 * 208; const float* p = tile_src(VN, a.cache_v, q0 - WIN + j, i < 208 * 16, ok); vq[it] = ((const f32x4*)p)[c4 & 15]; } }
            __syncthreads();
#pragma unroll
            for (int it = 0; it < 7; ++it) { const int i = tid + NWAVES * 64 * it;
                if (i < 208 * 16) { bool ok;
                    { const int j = i >> 4, c4 = i & 15; (void)tile_src(KN, a.cache_k, q0 - WIN + j, true, ok); const f32x4 kv = ok ? kq[it] : (f32x4){0.f, 0.f, 0.f, 0.f};
                      v2u kw; kw.x = cvtpk_c(kv.x, kv.y); kw.y = cvtpk_c(kv.z, kv.w); *(LAS v2u*)(Kt + j * 72 + 4 * c4) = kw; }
                    { const int c4 = i / 208, j = i - c4 * 208; (void)tile_src(VN, a.cache_v, q0 - WIN + j, true, ok); const f32x4 vv = ok ? vq[it] : (f32x4){0.f, 0.f, 0.f, 0.f};
                      Vt[(4 * c4 + 0) * 216 + j] = (bf16)f2bf(vv.x); Vt[(4 * c4 + 1) * 216 + j] = (bf16)f2bf(vv.y); Vt[(4 * c4 + 2) * 216 + j] = (bf16)f2bf(vv.z); Vt[(4 * c4 + 3) * 216 + j] = (bf16)f2bf(vv.w); } } }
            __syncthreads();
            cv_store(cqa, cva, cscr, lane);
            const CvItem cqb = cv_decode(a, ws, cvit + NGW); f32x4 cvb[8]; cv_load(cqb, cvb, lane);
            const int qh = kvh * 8 + wave; const float sink = a.b_sinks[qh];
            const int nqs = samp ? 1 : 4;
            for (int qs = 0; qs < nqs; ++qs) {
                const bool valid = samp ? lr < TS : true;
                const int mq = samp ? MP + b * TS + (lr & 7) : b * TP + q0 + 16 * qs + lr;
                pg8::bf16x8 bQ[2];
#pragma unroll
                for (int ks = 0; ks < 2; ++ks) bQ[ks] = *(const pg8::bf16x8*)(QB + (size_t)mq * D + qh * 64 + 32 * ks + 8 * lq);
                f32x4 sT[10];
#pragma unroll
                for (int j5 = 0; j5 < 2; ++j5) { pg8::bf16x8 aK[5][2];
#pragma unroll
                    for (int jj = 0; jj < 5; ++jj)
#pragma unroll
                        for (int ks = 0; ks < 2; ++ks) aK[jj][ks] = *(const LAS pg8::bf16x8*)(Kt + (16 * (qs + 5 * j5 + jj) + lr) * 72 + 32 * ks + 8 * lq);
                    __builtin_amdgcn_sched_barrier(0);
#pragma unroll
                    for (int jj = 0; jj < 5; ++jj) { sT[5 * j5 + jj] = (f32x4){0.f, 0.f, 0.f, 0.f};
#pragma unroll
                        for (int ks = 0; ks < 2; ++ks) sT[5 * j5 + jj] = __builtin_amdgcn_mfma_f32_16x16x32_bf16(aK[jj][ks], bQ[ks], sT[5 * j5 + jj], 0, 0, 0); }
                    __builtin_amdgcn_sched_barrier(0); }
                float mx = sink;
#pragma unroll
                for (int jt = 0; jt < 10; ++jt)
#pragma unroll
                    for (int r = 0; r < 4; ++r) { const int dpos = WIN + lr - 16 * jt - 4 * lq - r, kp = q0 - WIN + 16 * (qs + jt) + 4 * lq + r;
                        const bool ok = dpos >= 0 && dpos < WIN && kp >= 0;
                        sT[jt][r] = ok ? sT[jt][r] : -INFINITY; mx = fmaxf(mx, sT[jt][r]); }
                mx = fmaxf(mx, __shfl_xor(mx, 16)); mx = fmaxf(mx, __shfl_xor(mx, 32));
                float l = 0.f;
#pragma unroll
                for (int jt = 0; jt < 10; ++jt)
#pragma unroll
                    for (int r = 0; r < 4; ++r) { sT[jt][r] = __expf(sT[jt][r] - mx); l += sT[jt][r]; }
                l += __shfl_xor(l, 16); l += __shfl_xor(l, 32); l += __expf(sink - mx);
                f32x4 oT[4];
#pragma unroll
                for (int dt = 0; dt < 4; ++dt) oT[dt] = (f32x4){0.f, 0.f, 0.f, 0.f};
#pragma unroll
                for (int kk = 0; kk < 5; ++kk) {
                    v4u pw; pw.x = cvtpk_c(sT[2 * kk][0], sT[2 * kk][1]); pw.y = cvtpk_c(sT[2 * kk][2], sT[2 * kk][3]); pw.z = cvtpk_c(sT[2 * kk + 1][0], sT[2 * kk + 1][1]); pw.w = cvtpk_c(sT[2 * kk + 1][2], sT[2 * kk + 1][3]);
                    const pg8::bf16x8 bP = __builtin_bit_cast(pg8::bf16x8, pw);
                    v4u vw[4];
#pragma unroll
                    for (int dt = 0; dt < 4; ++dt) { const v2u v0 = *(const LAS v2u*)(Vt + (16 * dt + lr) * 216 + 16 * (qs + 2 * kk) + 4 * lq), v1 = *(const LAS v2u*)(Vt + (16 * dt + lr) * 216 + 16 * (qs + 2 * kk + 1) + 4 * lq);
                        vw[dt].x = v0.x; vw[dt].y = v0.y; vw[dt].z = v1.x; vw[dt].w = v1.y; }
                    __builtin_amdgcn_sched_barrier(0);
#pragma unroll
                    for (int dt = 0; dt < 4; ++dt) oT[dt] = __builtin_amdgcn_mfma_f32_16x16x32_bf16(__builtin_bit_cast(pg8::bf16x8, vw[dt]), bP, oT[dt], 0, 0, 0);
                    __builtin_amdgcn_sched_barrier(0); }
                if (valid) { const float inv = 1.0f / l;
#pragma unroll
                    for (int dt = 0; dt < 4; ++dt) { v2u ow; ow.x = cvtpk_c(oT[dt][0] * inv, oT[dt][1] * inv); ow.y = cvtpk_c(oT[dt][2] * inv, oT[dt][3] * inv);
                        *(v2u*)(ABUF + (size_t)mq * D + qh * 64 + 16 * dt + 4 * lq) = ow; } }
            }
            cv_store(cqb, cvb, cscr, lane);
        }
        __syncthreads();
    }
    SEAM(12);
    if (IN(13)) GEMM_N4096(ABUF, W_o, D, false, false, (const float*)nullptr);
    SEAM(13);
    if (IN(14)) norm_phase(Hres, HB16, a.norm_ffn + D, ABUF, SLAB, (LAS float*)(lds + RING_OFF), G, gw, NGW, lane, wave);
    SEAM(14);
    if (IN(15)) { pg8::Gemm g{ABUF, (const bf16*)(ws + WS_WGU1), M, NGU, D, D}; pg8::StaticOrder S; S.init(M, NGU, G, (int)blockIdx.x); pg8::EpiSwiGLU E{ACT, DFF};
        pg8::gemm_phase<pg8::EpiSwiGLU, pg8::StaticOrder, true, true>(lds + RING_OFF, g, S, E);
        if ((int)blockIdx.x >= LEFT_GU) convert_range<CV_PACE>(a, ws, CV_P12_END, CV_E_DN1, ((int)blockIdx.x - LEFT_GU) * NWAVES + wave, (G - LEFT_GU) * NWAVES, (LAS float*)(lds + RING_OFF + wave * 16384), lane); }
    SEAM(15);
    if (IN(16)) GEMM_N4096(ACT, (const bf16*)(ws + WS_WDN1), DFF, false, true, (const float*)nullptr);
    SEAM(16);
    if (IN(17)) {
        for (int r = blockIdx.x; r < MS; r += G) { const size_t ro = (size_t)(MP + r) * D + 4 * tid;
            f32x4 v0 = *(const f32x4*)(Hres + ro), v1 = *(const f32x4*)(Hres + ro + 2048); f32x4 p0[16], p1[16];
#pragma unroll
            for (int sp = 0; sp < 16; ++sp) { const bf16* q = SLAB + ((size_t)sp * MS + r) * D + 4 * tid; p0[sp] = bf4_to_f32(*(const v2u*)q); p1[sp] = bf4_to_f32(*(const v2u*)(q + 2048)); }
#pragma unroll
            for (int sp = 0; sp < 16; ++sp) { v0 += p0[sp]; v1 += p1[sp]; }
            *(f32x4*)(Hres + ro) = v0; *(f32x4*)(Hres + ro + 2048) = v1; }
    }
#undef IN
#undef SEAM
}

constexpr int NPHASES = 18;
extern "C" void kernel_launch(void* const* d_in, const int* in_sizes, int n_in, void* d_out, int out_size, void* d_ws, size_t ws_size, hipStream_t stream) {
    static int grid = 0;
    if (grid == 0) {
        if (n_in != 23 || out_size != (int)O_TOTAL || ws_size < WS_END) { fprintf(stderr, "kernel_launch: unexpected shapes (n_in %d, out %d, ws %zu, need %zu)\n", n_in, out_size, ws_size, (size_t)WS_END); grid = -1; return; }
        int dev = 0, cus = 0;
        if (hipGetDevice(&dev) != hipSuccess || hipDeviceGetAttribute(&cus, hipDeviceAttributeMultiprocessorCount, dev) != hipSuccess) { grid = -1; return; }
        if (hipFuncSetAttribute((const void*)yoco_fwd, hipFuncAttributeMaxDynamicSharedMemorySize, LDS_BYTES) != hipSuccess) { fprintf(stderr, "kernel_launch: hipFuncSetAttribute failed\n"); grid = -1; return; }
        int per_cu = 0;
        if (hipOccupancyMaxActiveBlocksPerMultiprocessor(&per_cu, (const void*)yoco_fwd, NWAVES * 64, LDS_BYTES) != hipSuccess || per_cu < 1) fprintf(stderr, "kernel_launch: occupancy query reports %d\n", per_cu);
        (void)hipGetLastError();
        if (cus != 256) { fprintf(stderr, "kernel_launch: built for a 256-CU device (got %d)\n", cus); grid = -1; return; }
        grid = cus;
    }
    if (grid < 0) return;
    (void)hipMemsetAsync((char*)d_ws + WS_CTL, 0, CTL_ZERO_BYTES, stream);
    Args a{};
    const float* const* in = (const float* const*)d_in;
    a.xp = in[0]; a.xs = in[1]; a.state_ssm = in[2]; a.state_conv = in[3]; a.cache_k = in[4]; a.cache_v = in[5]; a.norm_mix = in[6]; a.norm_ffn = in[7]; a.a_w_in = in[8]; a.a_conv_w = in[9];
    a.a_log = in[10]; a.a_dt_bias = in[11]; a.a_o_norm = in[12]; a.a_w_out = in[13]; a.kv_norm = in[14]; a.w_kv = in[15]; a.k_norm = in[16]; a.b_w_q = in[17]; a.b_q_norm = in[18]; a.b_sinks = in[19];
    a.b_w_o = in[20]; a.ffn_w_gu = in[21]; a.ffn_w_down = in[22];
    a.out = (float*)d_out; a.ws = (unsigned char*)d_ws; a.ph_lo = 0; a.ph_hi = NPHASES;
    hipLaunchKernelGGL(yoco_fwd, dim3(grid), dim3(NWAVES * 64), LDS_BYTES, stream, a);
}
```

```cpp
#include <hip/hip_runtime.h>
#include <cstdio>
#include <cstdint>
namespace pg8 {
#define PG8_LAS __attribute__((address_space(3)))
typedef unsigned short bf16_t;
typedef short bf16x8 __attribute__((ext_vector_type(8)));
typedef float f32x4 __attribute__((ext_vector_type(4)));
typedef unsigned u32x4 __attribute__((ext_vector_type(4)));
constexpr int BM = 256, BK = 64, HALF = 128, HTB = HALF * BK * 2  , STAGE_BYTES = 8 * HTB, NXCD = 8;

__host__ __device__ __forceinline__ int lds_byte(int r, int c) { const int st = (r >> 4) * 2 + (c >> 5), rr = r & 15, cc = c & 31, ob = rr * 64 + cc * 2; return st * 1024 + (ob ^ (((ob >> 9) & 1) << 5)); }
__host__ __device__ __forceinline__ void stage_rc(int b, int& R, int& C) { const int st = b / 1024, sb = b % 1024, swz = sb ^ (((sb >> 9) & 1) << 5); R = (st >> 1) * 16 + swz / 64; C = (st & 1) * 32 + (swz % 64) / 2; }
__host__ __device__ __forceinline__ int perm32(int rho) { const int n = rho >> 4, i = rho & 15; return 8 * (i >> 2) + 4 * n + (i & 3); }

struct Unit { int pm, pn; };
struct Gemm { const bf16_t* A; const bf16_t* Bt; int M, N, K, ld; };

struct StaticOrder {
    int nM, nN, nwg, G, c;
    __host__ __device__ void init(int M, int N, int G_, int c_) { nM = M / BM; nN = N / BM; nwg = nM * nN; G = G_; c = c_; }
    __host__ __device__ bool next(int i, Unit& u) const {
        const int x = c & 7, p = 32 * i + (c >> 3), s = p - 4 * nN;
        if (s < 0) { u.pn = p >> 2; u.pm = 4 * x + (p & 3); } else { if (!(nM & 1)) return false; u.pn = x + 8 * s; u.pm = nM - 1; }
        return u.pn < nN;
    }
    __device__ __forceinline__ void a_ready(const Unit&) const {}
    __device__ __forceinline__ void done(const Unit&) const {}
};

__device__ __forceinline__ unsigned cvt_pk_bf16(float lo, float hi) { unsigned r; asm volatile("v_cvt_pk_bf16_f32 %0, %1, %2" : "=v"(r) : "v"(lo), "v"(hi)); return r; }
struct EpiF32 {
    static constexpr bool PERM = false, AFTER_DRAIN = false;
    float* C; int ldc;
    __device__ __forceinline__ void operator()(const f32x4 (&acc)[2][2][4][2], const Unit& u, int wr, int wc, int fr, int fq) const {
        const int row0 = u.pm * BM + wr * 64 + fr, col0 = u.pn * BM + wc * 32 + 4 * fq;
#pragma unroll
        for (int ai = 0; ai < 2; ++ai)
#pragma unroll
            for (int m = 0; m < 4; ++m) { float* rowp = C + (size_t)(row0 + ai * HALF + m * 16) * ldc + col0;
#pragma unroll
                for (int bj = 0; bj < 2; ++bj)
#pragma unroll
                    for (int n = 0; n < 2; ++n) *(f32x4*)(rowp + bj * HALF + n * 16) = acc[ai][bj][m][n]; }
    }
};
struct EpiRes {
    static constexpr bool PERM = false, AFTER_DRAIN = false;
    const float* baseP; const float* baseS; int split_pm; float* out; int ldc;
    __device__ __forceinline__ void operator()(const f32x4 (&acc)[2][2][4][2], const Unit& u, int wr, int wc, int fr, int fq) const {
        const int row0 = u.pm * BM + wr * 64 + fr, col0 = u.pn * BM + wc * 32 + 4 * fq;
        const bool sp = u.pm >= split_pm; const float* bb = sp ? baseS : baseP; const int brow0 = sp ? row0 - split_pm * BM : row0;
#pragma unroll
        for (int ai = 0; ai < 2; ++ai)
#pragma unroll
            for (int m = 0; m < 4; ++m) { float* rowp = out + (size_t)(row0 + ai * HALF + m * 16) * ldc + col0; const float* bp = bb + (size_t)(brow0 + ai * HALF + m * 16) * ldc + col0;
                f32x4 bv[2][2];
#pragma unroll
                for (int bj = 0; bj < 2; ++bj)
#pragma unroll
                    for (int n = 0; n < 2; ++n) bv[bj][n] = *(const f32x4*)(bp + bj * HALF + n * 16);
#pragma unroll
                for (int bj = 0; bj < 2; ++bj)
#pragma unroll
                    for (int n = 0; n < 2; ++n) *(f32x4*)(rowp + bj * HALF + n * 16) = bv[bj][n] + acc[ai][bj][m][n]; }
    }
};
template <bool INF, bool OUTF>
struct EpiResT {
    static constexpr bool PERM = true, AFTER_DRAIN = false;
    const float* basef; float* outf; bf16_t* hb; int ldc;
    __device__ __forceinline__ void operator()(const f32x4 (&acc)[2][2][4][2], const Unit& u, int wr, int wc, int fr, int fq) const {
        const int row0 = u.pm * BM + wr * 64 + fr, col0 = u.pn * BM + wc * 32 + 8 * fq;
#pragma unroll
        for (int ai = 0; ai < 2; ++ai)
#pragma unroll
            for (int m = 0; m < 4; ++m) { const size_t ro = (size_t)(row0 + ai * HALF + m * 16) * ldc + col0;
                f32x4 bv[2][2];
#pragma unroll
                for (int bj = 0; bj < 2; ++bj) { const size_t o = ro + bj * HALF;
                    if constexpr (INF) { bv[bj][0] = *(const f32x4*)(basef + o); bv[bj][1] = *(const f32x4*)(basef + o + 4); }
                    else { const u32x4 w = *(const u32x4*)(hb + o);
                        bv[bj][0] = (f32x4){__builtin_bit_cast(float, w.x << 16), __builtin_bit_cast(float, w.x & 0xffff0000u), __builtin_bit_cast(float, w.y << 16), __builtin_bit_cast(float, w.y & 0xffff0000u)};
                        bv[bj][1] = (f32x4){__builtin_bit_cast(float, w.z << 16), __builtin_bit_cast(float, w.z & 0xffff0000u), __builtin_bit_cast(float, w.w << 16), __builtin_bit_cast(float, w.w & 0xffff0000u)}; } }
#pragma unroll
                for (int bj = 0; bj < 2; ++bj) { const size_t o = ro + bj * HALF; const f32x4 y0 = bv[bj][0] + acc[ai][bj][m][0], y1 = bv[bj][1] + acc[ai][bj][m][1];
                    if constexpr (OUTF) { *(f32x4*)(outf + o) = y0; *(f32x4*)(outf + o + 4) = y1; }
                    else { u32x4 w; w.x = cvt_pk_bf16(y0[0], y0[1]); w.y = cvt_pk_bf16(y0[2], y0[3]); w.z = cvt_pk_bf16(y1[0], y1[1]); w.w = cvt_pk_bf16(y1[2], y1[3]); *(u32x4*)(hb + o) = w; } } }
    }
};
struct EpiAtomic {
    static constexpr bool PERM = false, AFTER_DRAIN = false;
    float* out; int ldc;
    __device__ __forceinline__ void operator()(const f32x4 (&acc)[2][2][4][2], const Unit& u, int wr, int wc, int fr, int fq) const {
        const int row0 = u.pm * BM + wr * 64 + fr, col0 = u.pn * BM + wc * 32 + 4 * fq;
#pragma unroll
        for (int ai = 0; ai < 2; ++ai)
#pragma unroll
            for (int m = 0; m < 4; ++m) { float* rowp = out + (size_t)(row0 + ai * HALF + m * 16) * ldc + col0;
#pragma unroll
                for (int bj = 0; bj < 2; ++bj)
#pragma unroll
                    for (int n = 0; n < 2; ++n)
#pragma unroll
                        for (int j = 0; j < 4; ++j) __hip_atomic_fetch_add(rowp + bj * HALF + n * 16 + j, acc[ai][bj][m][n][j], __ATOMIC_RELAXED, __HIP_MEMORY_SCOPE_AGENT); }
    }
};
struct OneUnit {
    int pm, pn;
    __device__ __forceinline__ bool next(int i, Unit& u) const { if (i != 0) return false; u.pm = pm; u.pn = pn; return true; }
    __device__ __forceinline__ void a_ready(const Unit&) const {}
    __device__ __forceinline__ void done(const Unit&) const {}
};
__device__ __forceinline__ float silu_f(float x) { return x * __builtin_amdgcn_rcpf(1.0f + __expf(-x)); }
struct EpiSwiGLU {
    static constexpr bool PERM = true, AFTER_DRAIN = false;
    bf16_t* O; int ldc;
    __device__ __forceinline__ void operator()(const f32x4 (&acc)[2][2][4][2], const Unit& u, int wr, int wc, int fr, int fq) const {
        const int row0 = u.pm * BM + wr * 64 + fr, col0 = u.pn * HALF + wc * 32 + 8 * fq;
#pragma unroll
        for (int ai = 0; ai < 2; ++ai)
#pragma unroll
            for (int m = 0; m < 4; ++m) { bf16_t* rowp = O + (size_t)(row0 + ai * HALF + m * 16) * ldc + col0;
                const f32x4 g0 = acc[ai][0][m][0], g1 = acc[ai][0][m][1], u0 = acc[ai][1][m][0], u1 = acc[ai][1][m][1];
                u32x4 w; w.x = cvt_pk_bf16(silu_f(g0[0]) * u0[0], silu_f(g0[1]) * u0[1]); w.y = cvt_pk_bf16(silu_f(g0[2]) * u0[2], silu_f(g0[3]) * u0[3]);
                w.z = cvt_pk_bf16(silu_f(g1[0]) * u1[0], silu_f(g1[1]) * u1[1]); w.w = cvt_pk_bf16(silu_f(g1[2]) * u1[2], silu_f(g1[3]) * u1[3]);
                *(u32x4*)rowp = w; }
    }
};
template <class Epi, class Sched, bool ALIGN_EPI = false, bool SP2 = false>
__device__ __forceinline__ void gemm_phase(PG8_LAS unsigned char* lds, const Gemm g, const Sched& S, const Epi& E) {
    const int tid = threadIdx.x, wid = __builtin_amdgcn_readfirstlane(tid >> 6), lane = tid & 63, wr = wid >> 2, wc = wid & 3, fr = lane & 15, fq = lane >> 4;
    const int K = g.ld, nt = g.K / BK;
    unsigned voffA[2], voffB[2];
#pragma unroll
    for (int i = 0; i < 2; ++i) { int R, C; stage_rc(tid * 16 + i * 8192, R, C); const int Rb = Epi::PERM ? ((R & ~31) + perm32(R & 31)) : R;
        voffA[i] = (unsigned)(R * K + C) * 2u; voffB[i] = (unsigned)(Rb * K + C) * 2u; }
    const size_t kstep = (size_t)(BK * 2);
    const size_t hstep = (size_t)HALF * K * 2;
    const size_t tstep = 2 * hstep;
    const unsigned ldsw = (unsigned)wid * 1024u;
    const int aoff = lds_byte(wr * 64 + fr, fq * 8), boff = lds_byte(wc * 32 + fr, fq * 8);
#define PG8_SA(b, h) (((b) * 2 + (h)) * HTB)
#define PG8_SB(b, h) ((4 + (b) * 2 + (h)) * HTB)
#define PG8_STAGE(bufoff, gbase, voff) do { _Pragma("unroll") for (int _i = 0; _i < 2; ++_i) \
        __builtin_amdgcn_global_load_lds((const unsigned*)((const char*)(gbase) + (voff)[_i]), (PG8_LAS unsigned*)(lds + (bufoff) + ldsw + _i * 8192), 16, 0, 0); } while (0)
#define PG8_LDA(dst, b, h) do { _Pragma("unroll") for (int m = 0; m < 4; ++m) _Pragma("unroll") for (int k = 0; k < 2; ++k) dst[m][k] = *(const PG8_LAS bf16x8*)(lds + PG8_SA(b, h) + aoff + m * 2048 + k * 1024); } while (0)
#define PG8_LDB(dst, b, h) do { _Pragma("unroll") for (int n = 0; n < 2; ++n) _Pragma("unroll") for (int k = 0; k < 2; ++k) dst[n][k] = *(const PG8_LAS bf16x8*)(lds + PG8_SB(b, h) + boff + n * 2048 + k * 1024); } while (0)
#define PG8_MMA(ai, bj, At, Bt) do { __builtin_amdgcn_s_setprio(1); _Pragma("unroll") for (int m = 0; m < 4; ++m) _Pragma("unroll") for (int n = 0; n < 2; ++n) _Pragma("unroll") for (int k = 0; k < 2; ++k) \
        acc[ai][bj][m][n] = __builtin_amdgcn_mfma_f32_16x16x32_bf16(Bt[n][k], At[m][k], acc[ai][bj][m][n], 0, 0, 0); __builtin_amdgcn_s_setprio(0); } while (0)
#define PG8_WAIT_V(n) asm volatile("s_waitcnt vmcnt(" #n ")" ::: "memory")
#define PG8_WAIT_L(n) asm volatile("s_waitcnt lgkmcnt(" #n ")" ::: "memory")
#define PG8_BAR __builtin_amdgcn_s_barrier()
#define PG8_SCHED __builtin_amdgcn_sched_barrier(0)
    Unit cur, nxt; int ui = 0;
    if (!S.next(0, cur)) return;
    f32x4 acc[2][2][4][2];
#pragma unroll
    for (int a = 0; a < 2; ++a)
#pragma unroll
        for (int b = 0; b < 2; ++b)
#pragma unroll
            for (int m = 0; m < 4; ++m)
#pragma unroll
                for (int n = 0; n < 2; ++n) acc[a][b][m][n] = (f32x4){0.f, 0.f, 0.f, 0.f};
    bf16x8 At[4][2], B0[2][2], B1[2][2];
    const char* cA = (const char*)g.A + (size_t)cur.pm * tstep; const char* cB = (const char*)g.Bt + (size_t)cur.pn * tstep;
    S.a_ready(cur);
    if constexpr (SP2) {
        PG8_STAGE(PG8_SB(0, 0), cB, voffB); PG8_STAGE(PG8_SB(0, 1), cB + hstep, voffB); PG8_STAGE(PG8_SA(0, 0), cA, voffA); PG8_STAGE(PG8_SA(0, 1), cA + hstep, voffA);
        if (wr == 1) PG8_BAR;
        PG8_WAIT_V(2); PG8_BAR;
        PG8_STAGE(PG8_SB(1, 0), cB + kstep, voffB); PG8_STAGE(PG8_SA(1, 0), cA + kstep, voffA); PG8_STAGE(PG8_SB(1, 1), cB + hstep + kstep, voffB);
        PG8_WAIT_V(6); PG8_BAR;
    } else {
        PG8_STAGE(PG8_SB(0, 0), cB, voffB); PG8_STAGE(PG8_SA(0, 0), cA, voffA); PG8_STAGE(PG8_SB(0, 1), cB + hstep, voffB); PG8_STAGE(PG8_SA(0, 1), cA + hstep, voffA);
        if (wr == 1) PG8_BAR;
        PG8_WAIT_V(4); PG8_BAR;
        PG8_STAGE(PG8_SB(1, 0), cB + kstep, voffB); PG8_STAGE(PG8_SA(1, 0), cA + kstep, voffA); PG8_STAGE(PG8_SB(1, 1), cB + hstep + kstep, voffB);
        PG8_WAIT_V(6); PG8_BAR;
    }
    for (;;) {
        const bool has_next = S.next(ui + 1, nxt);
        const char* nA = has_next ? (const char*)g.A + (size_t)nxt.pm * tstep : cA; const char* nB = has_next ? (const char*)g.Bt + (size_t)nxt.pn * tstep : cB;
        for (int t = 0; t < nt; t += 2) {
            const bool last = (t == nt - 2);
            const char* a1 = cA + (size_t)(t + 1) * kstep;
            const char* a2 = last ? nA : cA + (size_t)(t + 2) * kstep; const char* b2 = last ? nB : cB + (size_t)(t + 2) * kstep;
            const char* a3 = a2 + kstep; const char* b3 = b2 + kstep;
            if (last && has_next) S.a_ready(nxt);
            if constexpr (SP2) {
            PG8_LDB(B0, 0, 0); PG8_LDB(B1, 0, 1); PG8_SCHED; PG8_LDA(At, 0, 0); PG8_STAGE(PG8_SA(1, 1), a1 + hstep, voffA);
            PG8_WAIT_V(8); PG8_WAIT_L(0); PG8_BAR; PG8_MMA(0, 0, At, B0); PG8_MMA(0, 1, At, B1); PG8_BAR; PG8_SCHED;
            PG8_LDA(At, 0, 1); PG8_STAGE(PG8_SB(0, 0), b2, voffB); PG8_STAGE(PG8_SB(0, 1), b2 + hstep, voffB); PG8_STAGE(PG8_SA(0, 0), a2, voffA);
            PG8_WAIT_V(8); PG8_WAIT_L(0); PG8_BAR; PG8_MMA(1, 0, At, B0); PG8_MMA(1, 1, At, B1); PG8_BAR; PG8_SCHED;
            PG8_LDB(B0, 1, 0); PG8_LDB(B1, 1, 1); PG8_SCHED; PG8_LDA(At, 1, 0); PG8_STAGE(PG8_SA(0, 1), a2 + hstep, voffA);
            PG8_WAIT_V(8); PG8_WAIT_L(0); PG8_BAR; PG8_MMA(0, 0, At, B0); PG8_MMA(0, 1, At, B1); PG8_BAR; PG8_SCHED;
            PG8_LDA(At, 1, 1); PG8_STAGE(PG8_SB(1, 0), b3, voffB); PG8_STAGE(PG8_SB(1, 1), b3 + hstep, voffB); PG8_STAGE(PG8_SA(1, 0), a3, voffA);
            PG8_WAIT_V(8); PG8_WAIT_L(0); PG8_BAR; PG8_MMA(1, 0, At, B0); PG8_MMA(1, 1, At, B1); PG8_BAR; PG8_SCHED;
            } else {
            PG8_LDB(B0, 0, 0); PG8_SCHED; PG8_LDA(At, 0, 0); PG8_STAGE(PG8_SA(1, 1), a1 + hstep, voffA);
            PG8_WAIT_L(8); PG8_BAR; PG8_WAIT_L(0); PG8_MMA(0, 0, At, B0); PG8_BAR; PG8_SCHED;
            PG8_LDB(B1, 0, 1); PG8_STAGE(PG8_SB(0, 0), b2, voffB);
            PG8_BAR; PG8_WAIT_L(0); PG8_MMA(0, 1, At, B1); PG8_BAR;
            PG8_LDA(At, 0, 1); PG8_STAGE(PG8_SA(0, 0), a2, voffA);
            PG8_BAR; PG8_WAIT_L(0); PG8_MMA(1, 0, At, B0); PG8_BAR; PG8_SCHED;
            PG8_STAGE(PG8_SB(0, 1), b2 + hstep, voffB);
            PG8_WAIT_V(6); PG8_BAR; PG8_MMA(1, 1, At, B1); PG8_BAR;
            PG8_LDB(B0, 1, 0); PG8_SCHED; PG8_LDA(At, 1, 0); PG8_STAGE(PG8_SA(0, 1), a2 + hstep, voffA);
            PG8_WAIT_L(8); PG8_BAR; PG8_WAIT_L(0); PG8_MMA(0, 0, At, B0); PG8_BAR; PG8_SCHED;
            PG8_LDB(B1, 1, 1); PG8_STAGE(PG8_SB(1, 0), b3, voffB);
            PG8_BAR; PG8_WAIT_L(0); PG8_MMA(0, 1, At, B1); PG8_BAR;
            PG8_LDA(At, 1, 1); PG8_STAGE(PG8_SA(1, 0), a3, voffA);
            PG8_BAR; PG8_WAIT_L(0); PG8_MMA(1, 0, At, B0); PG8_BAR; PG8_SCHED;
            PG8_STAGE(PG8_SB(1, 1), b3 + hstep, voffB);
            PG8_WAIT_V(6); PG8_BAR; PG8_MMA(1, 1, At, B1); PG8_BAR;
            }
        }
        if constexpr (ALIGN_EPI) { if (wr == 0) PG8_BAR; }
        if constexpr (!Epi::AFTER_DRAIN) { E(acc, cur, wr, wc, fr, fq); S.done(cur); }
        if (!has_next) break;
#pragma unroll
        for (int a = 0; a < 2; ++a)
#pragma unroll
            for (int b = 0; b < 2; ++b)
#pragma unroll
                for (int m = 0; m < 4; ++m)
#pragma unroll
                    for (int n = 0; n < 2; ++n) acc[a][b][m][n] = (f32x4){0.f, 0.f, 0.f, 0.f};
        cur = nxt; cA = nA; cB = nB; ++ui;
        if constexpr (ALIGN_EPI) { if (wr == 1) PG8_BAR; }
    }
    PG8_WAIT_V(0);
    if constexpr (!ALIGN_EPI) { if (wr == 0) PG8_BAR; }
    PG8_BAR;
    if constexpr (Epi::AFTER_DRAIN) { E.fused(acc, cur, wr, wc, fr, fq, lds, wid, lane); S.done(cur); }
#undef PG8_SA
#undef PG8_SB
#undef PG8_STAGE
#undef PG8_LDA
#undef PG8_LDB
#undef PG8_MMA
#undef PG8_WAIT_V
#undef PG8_WAIT_L
#undef PG8_BAR
#undef PG8_SCHED
}
}
constexpr int NWAVES = 8;
constexpr int D = 4096, MP = 8192, MS = 256, M = MP + MS;
constexpr int TP = 2048, BP = 4, BS = 32, TS = 8, NSEQ = BP + BS;
constexpr int HA = 32, DKA = 128, CCONV = 12288, APROJ = 16448, NPROJ = 16640;
constexpr int HB = 64, KVH = 8, HD = 64, KVW = 512, NKVQ = 5120, WIN = 128, PAST = 16384;
constexpr int DFF = 11008, NGU = 22016;
constexpr float EPS = 1e-6f;
constexpr size_t O_Y = 0, O_SSM_P = 34603008, O_CONV_P = 36700160, O_WK_P = 36847616, O_WV_P = 37109760,
                 O_SSM_S = 37371904, O_CONV_S = 54149120, O_WK_S = 55328768, O_WV_S = 57425920, O_TOTAL = 59523072;
constexpr size_t WS_CTL = 0, CTL_ZERO_BYTES = 32768;
constexpr size_t WS_WIN  = 1u << 20;
constexpr size_t WS_WOUT = WS_WIN  + (size_t)NPROJ * D * 2;
constexpr size_t WS_WGU0 = WS_WOUT + (size_t)D * D * 2;
constexpr size_t WS_WGU1 = WS_WGU0 + (size_t)NGU * D * 2;
constexpr size_t WS_WDN0 = WS_WGU1 + (size_t)NGU * D * 2;
constexpr size_t WS_WDN1 = WS_WDN0 + (size_t)D * DFF * 2;
constexpr size_t WS_WKVQ = WS_WDN1 + (size_t)D * DFF * 2;
constexpr size_t WS_WO   = WS_WKVQ + (size_t)NKVQ * D * 2;
constexpr size_t WS_ABUF = WS_WO   + (size_t)D * D * 2;
constexpr size_t WS_PROJ = WS_ABUF + (size_t)M * D * 2;
constexpr size_t WS_QKVC = WS_PROJ + (size_t)M * NPROJ * 4;
constexpr size_t WS_GATE = WS_QKVC + (size_t)M * CCONV * 4;
constexpr size_t WS_O    = WS_GATE + (size_t)M * HA * 4 * 2;
constexpr size_t WS_KN   = WS_O    + (size_t)M * D * 4;
constexpr size_t WS_VN   = WS_KN   + (size_t)M * KVW * 4;
constexpr int NCHUNK = BP * HA * (TP / 64);
constexpr size_t WS_WM   = WS_VN   + (size_t)M * KVW * 4;
constexpr size_t WS_QG   = WS_WM   + (size_t)NCHUNK * 64 * 128 * 2;
constexpr size_t WS_KDT  = WS_QG   + (size_t)NCHUNK * 64 * 128 * 2;
constexpr size_t WS_U0   = WS_KDT  + (size_t)NCHUNK * 128 * 64 * 2;
constexpr size_t WS_QKM  = WS_U0   + (size_t)NCHUNK * 64 * 128 * 4;
constexpr size_t WS_EGL  = WS_QKM  + (size_t)NCHUNK * 64 * 64 * 2;
constexpr size_t WS_SLAB = WS_EGL  + (size_t)NCHUNK * 4;
constexpr size_t WS_ROPE = WS_SLAB + (size_t)16 * MS * D * 4;
constexpr size_t WS_END  = WS_ROPE + (size_t)M * 16 * 4;
constexpr size_t WS_HB16 = WS_PROJ + (size_t)400 * 1024 * 1024;
static_assert((size_t)400 * 1024 * 1024 >= (size_t)M * 16384 * 2 + (size_t)64 * 1024 * 1024 + (size_t)M * 64 * 4 && (size_t)400 * 1024 * 1024 + (size_t)MP * D * 2 <= (size_t)M * NPROJ * 4, "HB16 placement");
constexpr size_t WS_ACT  = WS_PROJ;
constexpr size_t WS_KVQ  = WS_QKVC;
constexpr size_t WS_QN   = WS_O;
static_assert((size_t)M * DFF * 2 <= (size_t)M * NPROJ * 4 && (size_t)M * NKVQ * 4 <= (size_t)M * CCONV * 4, "overlays");
constexpr int CW_BAR = 4096;
constexpr int RING_OFF = 0, RING_BYTES = 131072;
constexpr int PREP_HALF = 72704;
constexpr int LDSCTL_OFF = 146432, MISC_OFF = LDSCTL_OFF + 320;
static_assert(2 * PREP_HALF <= LDSCTL_OFF && RING_BYTES <= LDSCTL_OFF, "LDS map");
constexpr int LDS_BYTES = 147456;

#define GAS __attribute__((address_space(1)))
#define LAS __attribute__((address_space(3)))
typedef unsigned short bf16;
typedef unsigned v4u __attribute__((ext_vector_type(4)));
typedef unsigned v2u __attribute__((ext_vector_type(2)));
typedef float f32x4 __attribute__((ext_vector_type(4)));
typedef float f32x2 __attribute__((ext_vector_type(2)));
#define LDS_WAIT() asm volatile("s_waitcnt lgkmcnt(0)" ::: "memory")
#define VM_WAIT() asm volatile("s_waitcnt vmcnt(0)" ::: "memory")
#define LDS_BARRIER() do { asm volatile("s_waitcnt lgkmcnt(0)" ::: "memory"); __builtin_amdgcn_s_barrier(); asm volatile("" ::: "memory"); } while (0)
__device__ __forceinline__ unsigned f2bf(float f) { unsigned u = __builtin_bit_cast(unsigned, f); return (u + 0x7fffu + ((u >> 16) & 1u)) >> 16; }
__device__ __forceinline__ unsigned pk2(float lo, float hi) { return f2bf(lo) | (f2bf(hi) << 16); }
typedef __bf16 bf16x2_t __attribute__((ext_vector_type(2)));
__device__ __forceinline__ unsigned cvtpk_c(float lo, float hi) { f32x2 v = {lo, hi}; bf16x2_t b = __builtin_convertvector(v, bf16x2_t); return __builtin_bit_cast(unsigned, b); }
#define XB_TMO      128
#define XB_XCNT(j)  (256  + 64 * (j))
#define XB_XSUB(j)  (1280 + 64 * (j))
#define XB_XGEN(j)  (2304 + 64 * (j))
#define XB_TOP      3328
#define XB_TOPGEN   3392
#define XCD_BAR_WORDS 3456
static_assert((size_t)(CW_BAR + XCD_BAR_WORDS) * 4 <= CTL_ZERO_BYTES, "the per-launch memset covers every barrier word");
#define XB_SPIN_CAP (1u << 18)

__device__ __forceinline__ unsigned xb_ld(unsigned* p)              { return __hip_atomic_load(p, __ATOMIC_RELAXED, __HIP_MEMORY_SCOPE_AGENT); }
__device__ __forceinline__ unsigned xb_add(unsigned* p, unsigned v) { return __hip_atomic_fetch_add(p, v, __ATOMIC_RELAXED, __HIP_MEMORY_SCOPE_AGENT); }
__device__ __forceinline__ unsigned xb_xcc_id() { return (unsigned)__builtin_amdgcn_s_getreg((3 << 11) | 20) & 0xFu; }
#define XB_SPIN(cond, bar) do { unsigned _sp = 0; while (cond) { __builtin_amdgcn_s_sleep(1); \
    if ((++_sp & 255u) == 0u) { if (xb_ld(&(bar)[XB_TMO])) break; if (_sp > XB_SPIN_CAP) { atomicAdd(&(bar)[XB_TMO], 1u); break; } } } } while (0)

struct XcdBarrier {
    unsigned* bar; unsigned x;
    volatile LAS unsigned* st;
};

__device__ __forceinline__ XcdBarrier xcd_barrier_post(unsigned* bar, volatile LAS unsigned* st) {
    XcdBarrier b; b.bar = bar; b.x = xb_xcc_id(); b.st = st;
    if (threadIdx.x == 0) (void)xb_add(&bar[XB_XCNT(b.x)], 1u);
    return b;
}
__device__ __forceinline__ void xcd_barrier_complete(unsigned* bar, unsigned x, unsigned& nloc, unsigned& nx) {
    const unsigned G = gridDim.x * gridDim.y * gridDim.z;
    unsigned sum, cnt, mine, sp = 0u;
    for (;;) {
        sum = 0u; cnt = 0u; mine = 0u;
#pragma unroll
        for (unsigned j = 0; j < 16; ++j) { const unsigned c = xb_ld(&bar[XB_XCNT(j)]); sum += c; cnt += (c > 0u) ? 1u : 0u; mine = (j == x) ? c : mine; }
        if (sum == G) break;
        __builtin_amdgcn_s_sleep(1);
        if ((++sp & 255u) == 0u) { if (xb_ld(&bar[XB_TMO])) break; if (sp > XB_SPIN_CAP) { atomicAdd(&bar[XB_TMO], 1u); break; } }
    }
    nloc = mine > 0u ? mine : 1u; nx = cnt > 0u ? cnt : 1u;
}

__device__ __forceinline__ void xcd_barrier(const XcdBarrier& b) {
    asm volatile("s_waitcnt vmcnt(0)" ::: "memory");
    __syncthreads();
    if (threadIdx.x == 0) {
        unsigned* bar = b.bar;
        __builtin_amdgcn_s_waitcnt(0);
        unsigned nloc = b.st[0], nx = b.st[1];
        if (nloc == 0u) { xcd_barrier_complete(bar, b.x, nloc, nx); b.st[0] = nloc; b.st[1] = nx; }
        const unsigned old = xb_add(&bar[XB_XSUB(b.x)], 1u);
        const unsigned gen = old / nloc;
        if (old + 1u == (gen + 1u) * nloc) {
            __builtin_amdgcn_fence(__ATOMIC_RELEASE, "agent");
            asm volatile("s_waitcnt vmcnt(0)" ::: "memory");
            const unsigned og = xb_add(&bar[XB_TOP], 1u);
            const unsigned tg = og / nx;
            if (og + 1u == (tg + 1u) * nx) xb_add(&bar[XB_TOPGEN], 1u);
            else XB_SPIN(xb_ld(&bar[XB_TOPGEN]) == tg, bar);
            __builtin_amdgcn_fence(__ATOMIC_ACQUIRE, "agent");
            xb_add(&bar[XB_XGEN(b.x)], 1u);
            asm volatile("s_waitcnt vmcnt(0)" ::: "memory");
        } else {
            XB_SPIN(xb_ld(&bar[XB_XGEN(b.x)]) == gen, bar);
            __builtin_amdgcn_fence(__ATOMIC_ACQUIRE, "agent");
            asm volatile("s_waitcnt vmcnt(0)" ::: "memory");
        }
    }
    __syncthreads();
}
struct EpiProj {
    static constexpr bool PERM = true, AFTER_DRAIN = false;
    bf16* P; float* GR;
    __device__ __forceinline__ void operator()(const f32x4 (&acc)[2][2][4][2], const pg8::Unit& u, int wr, int wc, int fr, int fq) const {
        const int row0 = u.pm * 256 + wr * 64 + fr;
        if (u.pn < 64) { const int col0 = u.pn * 256 + wc * 32 + 8 * fq;
#pragma unroll
            for (int ai = 0; ai < 2; ++ai)
#pragma unroll
                for (int m = 0; m < 4; ++m) { bf16* rowp = P + (size_t)(row0 + ai * 128 + m * 16) * 16384 + col0;
#pragma unroll
                    for (int bj = 0; bj < 2; ++bj) { const f32x4 v0 = acc[ai][bj][m][0], v1 = acc[ai][bj][m][1];
                        v4u w; w.x = cvtpk_c(v0[0], v0[1]); w.y = cvtpk_c(v0[2], v0[3]); w.z = cvtpk_c(v1[0], v1[1]); w.w = cvtpk_c(v1[2], v1[3]); *(v4u*)(rowp + bj * 128) = w; } }
        } else if (wc < 2) {
#pragma unroll
            for (int ai = 0; ai < 2; ++ai)
#pragma unroll
                for (int m = 0; m < 4; ++m) { float* rowp = GR + (size_t)(row0 + ai * 128 + m * 16) * 64 + wc * 32 + 8 * fq;
                    *(f32x4*)rowp = acc[ai][0][m][0]; *(f32x4*)(rowp + 4) = acc[ai][0][m][1]; }
        }
    }
};
struct EpiSlab {
    static constexpr bool PERM = true, AFTER_DRAIN = false;
    bf16* S; int ldc;
    __device__ __forceinline__ void operator()(const f32x4 (&acc)[2][2][4][2], const pg8::Unit& u, int wr, int wc, int fr, int fq) const {
        const int row0 = u.pm * 256 + wr * 64 + fr, col0 = u.pn * 256 + wc * 32 + 8 * fq;
#pragma unroll
        for (int ai = 0; ai < 2; ++ai)
#pragma unroll
            for (int m = 0; m < 4; ++m) { bf16* rowp = S + (size_t)(row0 + ai * 128 + m * 16) * ldc + col0;
#pragma unroll
                for (int bj = 0; bj < 2; ++bj) { const f32x4 v0 = acc[ai][bj][m][0], v1 = acc[ai][bj][m][1];
                    v4u w; w.x = cvtpk_c(v0[0], v0[1]); w.y = cvtpk_c(v0[2], v0[3]); w.z = cvtpk_c(v1[0], v1[1]); w.w = cvtpk_c(v1[2], v1[3]); *(v4u*)(rowp + bj * 128) = w; } }
    }
};
__device__ __forceinline__ f32x4 bf4_to_f32(v2u w) { return (f32x4){__builtin_bit_cast(float, w.x << 16), __builtin_bit_cast(float, w.x & 0xffff0000u), __builtin_bit_cast(float, w.y << 16), __builtin_bit_cast(float, w.y & 0xffff0000u)}; }
struct EpiKVQ {
    static constexpr bool PERM = false, AFTER_DRAIN = false;
    float* KN; float* VN; bf16* QB; const float* rope; const float* k_norm; const float* q_norm; float* out;
    __device__ __forceinline__ void operator()(const f32x4 (&acc)[2][2][4][2], const pg8::Unit& u, int wr, int wc, int fr, int fq) const {
        const int s = 4 * u.pn + wc, row0 = u.pm * 256 + wr * 64 + fr;
        if (u.pn >= 2 && u.pn < 4) {
            const int kvh = s - 8;
#pragma unroll
            for (int ai = 0; ai < 2; ++ai)
#pragma unroll
                for (int m = 0; m < 4; ++m) { const int row = row0 + ai * 128 + m * 16; const bool samp = row >= MP; const int b = samp ? (row - MP) >> 3 : row >> 11, t = samp ? (row - MP) & 7 : row & 2047;
                    float* vp = VN + (size_t)row * KVW + kvh * 64 + 4 * fq;
                    float* wp = samp ? out + O_WV_S + ((size_t)b * WIN + (WIN - TS + t)) * KVW + kvh * 64 + 4 * fq : (t >= TP - WIN ? out + O_WV_P + ((size_t)b * WIN + (t - (TP - WIN))) * KVW + kvh * 64 + 4 * fq : nullptr);
#pragma unroll
                    for (int bj = 0; bj < 2; ++bj)
#pragma unroll
                        for (int n = 0; n < 2; ++n) { *(f32x4*)(vp + 32 * bj + 16 * n) = acc[ai][bj][m][n]; if (wp) *(f32x4*)(wp + 32 * bj + 16 * n) = acc[ai][bj][m][n]; } }
            return;
        }
        const bool isk = u.pn < 2; const float* nwp = isk ? k_norm : q_norm;
        f32x4 nw[2][2];
#pragma unroll
        for (int bj = 0; bj < 2; ++bj)
#pragma unroll
            for (int n = 0; n < 2; ++n) nw[bj][n] = *(const f32x4*)(nwp + 32 * bj + 16 * n + 4 * fq);
#pragma unroll
        for (int ai = 0; ai < 2; ++ai)
#pragma unroll
            for (int m = 0; m < 4; ++m) { const int row = row0 + ai * 128 + m * 16;
                float ss = 0.f;
#pragma unroll
                for (int bj = 0; bj < 2; ++bj)
#pragma unroll
                    for (int n = 0; n < 2; ++n) { const f32x4 v = acc[ai][bj][m][n]; ss += (v.x * v.x + v.y * v.y) + (v.z * v.z + v.w * v.w); }
                ss += __shfl_xor(ss, 16); ss += __shfl_xor(ss, 32);
                const float r = 1.0f / sqrtf(ss * (1.0f / 64.0f) + EPS);
                f32x4 y[2][2];
#pragma unroll
                for (int bj = 0; bj < 2; ++bj)
#pragma unroll
                    for (int n = 0; n < 2; ++n) y[bj][n] = acc[ai][bj][m][n] * r * nw[bj][n];
                const f32x4 cs = *(const f32x4*)(rope + (size_t)row * 16 + 4 * (fq & 1)), sn = *(const f32x4*)(rope + (size_t)row * 16 + 8 + 4 * (fq & 1));
                f32x4 p; p.x = __shfl_xor(y[0][0].x, 32); p.y = __shfl_xor(y[0][0].y, 32); p.z = __shfl_xor(y[0][0].z, 32); p.w = __shfl_xor(y[0][0].w, 32);
                y[0][0] = (fq < 2) ? y[0][0] * cs - p * sn : y[0][0] * cs + p * sn;
                if (isk) { const bool samp = row >= MP; const int b = samp ? (row - MP) >> 3 : row >> 11, t = samp ? (row - MP) & 7 : row & 2047;
                    float* kp = KN + (size_t)row * KVW + s * 64 + 4 * fq;
                    float* wp = samp ? out + O_WK_S + ((size_t)b * WIN + (WIN - TS + t)) * KVW + s * 64 + 4 * fq : (t >= TP - WIN ? out + O_WK_P + ((size_t)b * WIN + (t - (TP - WIN))) * KVW + s * 64 + 4 * fq : nullptr);
#pragma unroll
                    for (int bj = 0; bj < 2; ++bj)
#pragma unroll
                        for (int n = 0; n < 2; ++n) { *(f32x4*)(kp + 32 * bj + 16 * n) = y[bj][n]; if (wp) *(f32x4*)(wp + 32 * bj + 16 * n) = y[bj][n]; }
                } else { bf16* qp = QB + (size_t)row * D + (s - 16) * 64 + 4 * fq;
#pragma unroll
                    for (int bj = 0; bj < 2; ++bj)
#pragma unroll
                        for (int n = 0; n < 2; ++n) { const f32x4 z = y[bj][n] * 0.125f; v2u w; w.x = cvtpk_c(z.x, z.y); w.y = cvtpk_c(z.z, z.w); *(v2u*)(qp + 32 * bj + 16 * n) = w; } }
            }
    }
};

struct Args {
    const float *xp, *xs, *state_ssm, *state_conv, *cache_k, *cache_v, *norm_mix, *norm_ffn, *a_w_in, *a_conv_w, *a_log, *a_dt_bias, *a_o_norm, *a_w_out,
                *kv_norm, *w_kv, *k_norm, *b_w_q, *b_q_norm, *b_sinks, *b_w_o, *ffn_w_gu, *ffn_w_down;
    float* out; unsigned char* ws; int ph_lo, ph_hi;
};
static_assert(sizeof(Args) == 25 * 8 + 8, "Args has no padding");

__device__ __forceinline__ float wave_sum(float v) {
#pragma unroll
    for (int o = 1; o < 64; o <<= 1) v += __shfl_xor(v, o);
    return v;
}
__device__ __forceinline__ float silu_acc(float x) { return x / (1.0f + expf(-x)); }

__device__ __forceinline__ void tr_item(const float* __restrict__ src, int ldsrc, int c0, const float* __restrict__ gain, bf16* __restrict__ dst, int K, int r0, int k0, LAS float* scr, int lane) {
#pragma unroll 8
    for (int i = 0; i < 32; ++i) { const int kk = 2 * i + (lane >> 5); float v = src[(size_t)(k0 + kk) * ldsrc + c0 + (lane & 31)]; if (gain) v *= gain[k0 + kk]; scr[kk * 33 + (lane & 31)] = v; }
    LDS_WAIT(); asm volatile("" ::: "memory");
    const int c = lane & 7;
#pragma unroll
    for (int j = 0; j < 4; ++j) { const int n = (lane >> 3) + 8 * j; const LAS float* s = scr + (8 * c) * 33 + n;
        v4u o; o.x = pk2(s[0 * 33], s[1 * 33]); o.y = pk2(s[2 * 33], s[3 * 33]); o.z = pk2(s[4 * 33], s[5 * 33]); o.w = pk2(s[6 * 33], s[7 * 33]);
        *(v4u*)(dst + (size_t)(r0 + n) * K + k0 + 8 * c) = o; }
    LDS_WAIT(); asm volatile("" ::: "memory");
}
__device__ __forceinline__ void rms_gain_load(const float* __restrict__ gain, f32x4 (&g)[16], int lane) {
#pragma unroll
    for (int j = 0; j < 16; ++j) g[j] = gain ? ((const f32x4*)gain)[lane + 64 * j] : (f32x4){1.f, 1.f, 1.f, 1.f};
}
__device__ __forceinline__ void rms_row_bf16(const float* __restrict__ xr, const f32x4 (&g)[16], bf16* __restrict__ orow, int lane) {
    const f32x4* p = (const f32x4*)xr + lane; f32x4 v[16]; float s = 0.f;
#pragma unroll
    for (int j = 0; j < 16; ++j) { v[j] = p[64 * j]; s += (v[j].x * v[j].x + v[j].y * v[j].y) + (v[j].z * v[j].z + v[j].w * v[j].w); }
    const float rstd = 1.0f / sqrtf(wave_sum(s) * (1.0f / D) + EPS);
    v2u* o8 = (v2u*)orow + lane;
#pragma unroll
    for (int j = 0; j < 16; ++j) { const f32x4 y = v[j] * rstd * g[j];
        v2u w; w.x = pk2(y.x, y.y); w.y = pk2(y.z, y.w); o8[64 * j] = w; }
}
__device__ __forceinline__ void rms_gain_load8(const float* __restrict__ gain, f32x4 (&g)[16], int lane) {
#pragma unroll
    for (int j = 0; j < 8; ++j) { g[2 * j] = gain ? ((const f32x4*)gain)[2 * (lane + 64 * j)] : (f32x4){1.f, 1.f, 1.f, 1.f}; g[2 * j + 1] = gain ? ((const f32x4*)gain)[2 * (lane + 64 * j) + 1] : (f32x4){1.f, 1.f, 1.f, 1.f}; }
}
__device__ __forceinline__ void rms_row_from_bf16(const bf16* __restrict__ xr, const f32x4 (&g)[16], bf16* __restrict__ orow, int lane) {
    const v4u* p = (const v4u*)xr + lane; v4u r[8]; float s = 0.f;
#pragma unroll
    for (int j = 0; j < 8; ++j) r[j] = p[64 * j];
#pragma unroll
    for (int j = 0; j < 8; ++j) { const f32x4 a0 = bf4_to_f32((v2u){r[j].x, r[j].y}), a1 = bf4_to_f32((v2u){r[j].z, r[j].w});
        s += ((a0.x * a0.x + a0.y * a0.y) + (a0.z * a0.z + a0.w * a0.w)) + ((a1.x * a1.x + a1.y * a1.y) + (a1.z * a1.z + a1.w * a1.w)); }
    const float rstd = 1.0f / sqrtf(wave_sum(s) * (1.0f / D) + EPS);
    v4u* o8 = (v4u*)orow + lane;
#pragma unroll
    for (int j = 0; j < 8; ++j) { const f32x4 a0 = bf4_to_f32((v2u){r[j].x, r[j].y}), a1 = bf4_to_f32((v2u){r[j].z, r[j].w});
        const f32x4 y0 = a0 * rstd * g[2 * j], y1 = a1 * rstd * g[2 * j + 1];
        v4u w; w.x = pk2(y0.x, y0.y); w.y = pk2(y0.z, y0.w); w.z = pk2(y1.x, y1.y); w.w = pk2(y1.z, y1.w); o8[64 * j] = w; }
}
__device__ __forceinline__ void norm_phase(float* __restrict__ H, const bf16* __restrict__ Hb, const float* __restrict__ gain, bf16* __restrict__ A, const bf16* __restrict__ slab, LAS float* red, int G, int gw, int NGW, int lane, int wave) {
    { f32x4 gv[16]; rms_gain_load8(gain, gv, lane);
      for (int m = gw; m < MP; m += NGW) rms_row_from_bf16(Hb + (size_t)m * D, gv, A + (size_t)m * D, lane); }
    for (int r = blockIdx.x; r < MS; r += G) {
        const size_t ro = (size_t)(MP + r) * D + 512 * wave + 4 * lane;
        f32x4 v0 = *(const f32x4*)(H + ro), v1 = *(const f32x4*)(H + ro + 256);
        f32x4 p0[16], p1[16];
#pragma unroll
        for (int sp = 0; sp < 16; ++sp) { const bf16* q = slab + ((size_t)sp * MS + r) * D + 512 * wave + 4 * lane; p0[sp] = bf4_to_f32(*(const v2u*)q); p1[sp] = bf4_to_f32(*(const v2u*)(q + 256)); }
#pragma unroll
        for (int sp = 0; sp < 16; ++sp) { v0 += p0[sp]; v1 += p1[sp]; }
        *(f32x4*)(H + ro) = v0; *(f32x4*)(H + ro + 256) = v1;
        float s = wave_sum((v0.x * v0.x + v0.y * v0.y) + (v0.z * v0.z + v0.w * v0.w) + (v1.x * v1.x + v1.y * v1.y) + (v1.z * v1.z + v1.w * v1.w));
        __syncthreads();
        if (lane == 0) red[wave] = s;
        __syncthreads();
        s = ((red[0] + red[1]) + (red[2] + red[3])) + ((red[4] + red[5]) + (red[6] + red[7]));
        const float rstd = 1.0f / sqrtf(s * (1.0f / D) + EPS);
        const f32x4 g0 = gain ? *(const f32x4*)(gain + 512 * wave + 4 * lane) : (f32x4){1.f, 1.f, 1.f, 1.f}, g1 = gain ? *(const f32x4*)(gain + 512 * wave + 4 * lane + 256) : (f32x4){1.f, 1.f, 1.f, 1.f};
        const f32x4 y0 = v0 * rstd * g0, y1 = v1 * rstd * g1;
        v2u w0, w1; w0.x = pk2(y0.x, y0.y); w0.y = pk2(y0.z, y0.w); w1.x = pk2(y1.x, y1.y); w1.y = pk2(y1.z, y1.w);
        *(v2u*)(A + ro) = w0; *(v2u*)(A + ro + 256) = w1;
    }
}

constexpr int CV_KB = D / 64;
constexpr int CV_IN = CV_KB * (APROJ / 32), CV_OUT = CV_KB * (D / 32), CV_GU = CV_KB * (NGU / 32), CV_DN = (DFF / 64) * (D / 32), CV_KVQ = CV_KB * (NKVQ / 32), CV_O = CV_KB * (D / 32);
constexpr int CV_E_IN = CV_IN, CV_E_OUT = CV_E_IN + CV_OUT, CV_E_GU0 = CV_E_OUT + CV_GU, CV_E_DN0 = CV_E_GU0 + CV_DN, CV_E_KVQ = CV_E_DN0 + CV_KVQ, CV_E_O = CV_E_KVQ + CV_O, CV_E_GU1 = CV_E_O + CV_GU, CV_E_DN1 = CV_E_GU1 + CV_DN;
constexpr int LEFT_P1 = (M / 256) * (NPROJ / 256) % 256, LEFT_GU = (M / 256) * (NGU / 256) % 256, LEFT_KVQ = (M / 256) * (NKVQ / 256) % 256;
#ifndef CV_PACE
#define CV_PACE 0
#endif
#ifndef CV_N1
#define CV_N1 22
#endif
#ifndef CV_N7
#define CV_N7 22
#endif
#ifndef CV_N10
#define CV_N10 24
#endif
constexpr int CV_N12 = 2, ATT_UNITS_PER_WG = 5;
constexpr int CV_CAP1 = (256 - LEFT_P1) * NWAVES * CV_N1, CV_CAP7 = (256 - LEFT_GU) * NWAVES * CV_N7, CV_CAP10 = (256 - LEFT_KVQ) * NWAVES * CV_N10, CV_CAP12 = ATT_UNITS_PER_WG * CV_N12 * 256 * NWAVES;
constexpr int cv_max(int x, int y) { return x > y ? x : y; }
constexpr int CV_P0_END = cv_max(cv_max(CV_E_IN, CV_E_GU0 - CV_CAP1), cv_max(CV_E_KVQ - CV_CAP1 - CV_CAP7, CV_E_GU1 - CV_CAP1 - CV_CAP7 - CV_CAP10 - CV_CAP12));
constexpr int CV_P1_END = CV_P0_END + CV_CAP1, CV_P7_END = CV_P1_END + CV_CAP7, CV_P10_END = CV_P7_END + CV_CAP10, CV_P12_END = CV_P10_END + CV_CAP12;
static_assert(CV_P0_END >= CV_E_IN && CV_P1_END >= CV_E_GU0 && CV_P7_END >= CV_E_KVQ && CV_P12_END >= CV_E_GU1 && CV_P12_END <= CV_E_DN1, "conversion schedule: every copy is complete a barrier ahead of its GEMM");
struct CvItem { const float* src; const float* gain; bf16* dst; int ldsrc, c0, K, r0, k0; };
__device__ __forceinline__ CvItem cv_decode(const Args& a, unsigned char* ws, int it) {
    CvItem q; q.gain = nullptr; q.K = D; int r = it;
    if (r < CV_E_IN) { const int nblk = APROJ / 32, kb = r / nblk, nb = r % nblk; q.src = a.a_w_in; q.ldsrc = APROJ; q.c0 = 32 * nb; q.dst = (bf16*)(ws + WS_WIN); q.r0 = 32 * nb; q.k0 = 64 * kb; }
    else if (r < CV_E_OUT) { r -= CV_E_IN; const int nblk = D / 32, kb = r / nblk, nb = r % nblk; q.src = a.a_w_out; q.ldsrc = D; q.c0 = 32 * nb; q.dst = (bf16*)(ws + WS_WOUT); q.r0 = 32 * nb; q.k0 = 64 * kb; }
    else if (r < CV_E_GU0 || (r >= CV_E_O && r < CV_E_GU1)) { const int l = r >= CV_E_O; r -= l ? CV_E_O : CV_E_OUT; const int nblk = NGU / 32, kb = r / nblk, nb = r % nblk; q.r0 = 32 * nb; q.k0 = 64 * kb;
        const int pn = q.r0 >> 8, within = q.r0 & 255; q.c0 = (within >> 7) * DFF + 128 * pn + (within & 127);
        q.src = a.ffn_w_gu + (size_t)l * D * NGU; q.ldsrc = NGU; q.dst = (bf16*)(ws + (l ? WS_WGU1 : WS_WGU0)); }
    else if (r < CV_E_DN0 || r >= CV_E_GU1) { const int l = r >= CV_E_GU1; r -= l ? CV_E_GU1 : CV_E_GU0; const int nblk = D / 32, kb = r / nblk, nb = r % nblk;
        q.src = a.ffn_w_down + (size_t)l * DFF * D; q.ldsrc = D; q.c0 = 32 * nb; q.dst = (bf16*)(ws + (l ? WS_WDN1 : WS_WDN0)); q.K = DFF; q.r0 = 32 * nb; q.k0 = 64 * kb; }
    else if (r < CV_E_KVQ) { r -= CV_E_DN0; const int nblk = NKVQ / 32, kb = r / nblk, nb = r % nblk; q.r0 = 32 * nb; q.k0 = 64 * kb;
        const int hs = 4 * (q.r0 >> 8) + ((q.r0 >> 5) & 3); q.c0 = 64 * hs + 32 * ((q.r0 >> 7) & 1); q.dst = (bf16*)(ws + WS_WKVQ);
        if (hs < 16) { q.src = a.w_kv; q.ldsrc = 2 * KVW; q.gain = a.kv_norm; } else { q.src = a.b_w_q; q.ldsrc = D; q.c0 -= 2 * KVW; q.gain = a.norm_mix + D; } }
    else { r -= CV_E_KVQ; const int nblk = D / 32, kb = r / nblk, nb = r % nblk; q.src = a.b_w_o; q.ldsrc = D; q.c0 = 32 * nb; q.dst = (bf16*)(ws + WS_WO); q.r0 = 32 * nb; q.k0 = 64 * kb; }
    return q;
}
__device__ __forceinline__ void cv_load(const CvItem& q, f32x4 (&v)[8], int lane) {
#pragma unroll
    for (int i = 0; i < 8; ++i) v[i] = __builtin_nontemporal_load((const f32x4*)(q.src + (size_t)(q.k0 + 8 * i + (lane >> 3)) * q.ldsrc + q.c0 + 4 * (lane & 7)));
}
__device__ __forceinline__ void cv_store(const CvItem& q, const f32x4 (&v)[8], LAS float* scr, int lane) {
#pragma unroll
    for (int i = 0; i < 8; ++i) { LAS float* w = scr + (8 * i + (lane >> 3)) * 33 + 4 * (lane & 7); w[0] = v[i].x; w[1] = v[i].y; w[2] = v[i].z; w[3] = v[i].w; }
    LDS_WAIT(); asm volatile("" ::: "memory");
    const int c = lane & 7;
    f32x4 ga = {1.f, 1.f, 1.f, 1.f}, gb = {1.f, 1.f, 1.f, 1.f}; if (q.gain) { ga = *(const f32x4*)(q.gain + q.k0 + 8 * c); gb = *(const f32x4*)(q.gain + q.k0 + 8 * c + 4); }
#pragma unroll
    for (int j = 0; j < 4; ++j) { const int n = (lane >> 3) + 8 * j; const LAS float* s = scr + (8 * c) * 33 + n;
        v4u o; o.x = pk2(s[0 * 33] * ga.x, s[1 * 33] * ga.y); o.y = pk2(s[2 * 33] * ga.z, s[3 * 33] * ga.w); o.z = pk2(s[4 * 33] * gb.x, s[5 * 33] * gb.y); o.w = pk2(s[6 * 33] * gb.z, s[7 * 33] * gb.w);
        *(v4u*)(q.dst + (size_t)(q.r0 + n) * q.K + q.k0 + 8 * c) = o; }
    LDS_WAIT(); asm volatile("" ::: "memory");
}
constexpr int CV_DEPTH = 4;
template <int PACE>
__device__ __forceinline__ void convert_range(const Args& a, unsigned char* ws, int lo, int hi, int worker, int nworkers, LAS float* scr, int lane) {
    int it = lo + worker; if (it >= hi) return;
    CvItem q[CV_DEPTH]; f32x4 v[CV_DEPTH][8];
#pragma unroll
    for (int d = 0; d < CV_DEPTH - 1; ++d) { const int id = it + d * nworkers; q[d] = cv_decode(a, ws, id < hi ? id : it); cv_load(q[d], v[d], lane); }
    for (;;) {
#pragma unroll
        for (int d = 0; d < CV_DEPTH; ++d) {
            const int sp = (d + CV_DEPTH - 1) % CV_DEPTH, ip = it + (CV_DEPTH - 1) * nworkers;
            q[sp] = cv_decode(a, ws, ip < hi ? ip : it); cv_load(q[sp], v[sp], lane);
            cv_store(q[d], v[d], scr, lane); if (PACE) __builtin_amdgcn_s_sleep(PACE);
            it += nworkers; if (it >= hi) return;
        }
    }
}

__global__ void __launch_bounds__(NWAVES * 64, 2) yoco_fwd(Args a) {
    extern __shared__ __attribute__((aligned(16))) unsigned char lds_raw[];
    LAS unsigned char* lds = (LAS unsigned char*)lds_raw;
    const int tid = threadIdx.x, lane = tid & 63, wave = __builtin_amdgcn_readfirstlane(tid >> 6);
    const int G = gridDim.x, gw = blockIdx.x * NWAVES + wave, NGW = G * NWAVES;
    unsigned char* ws = a.ws;
    unsigned* ctl = (unsigned*)(ws + WS_CTL);
    for (int u = tid; u < (LDS_BYTES - LDSCTL_OFF) / 4; u += NWAVES * 64) ((LAS unsigned*)(lds + LDSCTL_OFF))[u] = 0u;
    __syncthreads();
    volatile LAS unsigned* MISC = (volatile LAS unsigned*)(lds + MISC_OFF);
    XcdBarrier bar = xcd_barrier_post(ctl + CW_BAR, MISC + 8);
    const int lo = a.ph_lo, hi = a.ph_hi;
#define IN(k) (lo <= (k) && (k) < hi)
#define SEAM(k) do { if (IN(k) && IN((k) + 1)) xcd_barrier(bar); } while (0)

    bf16* W_in = (bf16*)(ws + WS_WIN); bf16* W_out = (bf16*)(ws + WS_WOUT); bf16* W_kvq = (bf16*)(ws + WS_WKVQ); bf16* W_o = (bf16*)(ws + WS_WO);
    bf16* ABUF = (bf16*)(ws + WS_ABUF); bf16* PROJB = (bf16*)(ws + WS_PROJ); float* GR = (float*)(ws + WS_PROJ + (size_t)M * 16384 * 2 + (size_t)64 * 1024 * 1024);    float* QKVC = (float*)(ws + WS_QKVC);
    float* GG = (float*)(ws + WS_GATE); float* BETA = GG + (size_t)M * HA; bf16* OB = (bf16*)(ws + WS_O);
    float* KN = (float*)(ws + WS_KN); float* VN = (float*)(ws + WS_VN); bf16* ACT = (bf16*)(ws + WS_ACT); float* KVQ = (float*)(ws + WS_KVQ); bf16* QB = (bf16*)(ws + WS_QN);
    bf16* WMb = (bf16*)(ws + WS_WM); bf16* QGb = (bf16*)(ws + WS_QG); bf16* KDTb = (bf16*)(ws + WS_KDT); bf16* U0c = (bf16*)(ws + WS_U0); bf16* QKMb = (bf16*)(ws + WS_QKM); float* EGLb = (float*)(ws + WS_EGL);
    bf16* SLAB = (bf16*)(ws + WS_SLAB); float* ROPE = (float*)(ws + WS_ROPE); bf16* HB16 = (bf16*)(ws + WS_HB16);
    float* Hres = a.out + O_Y;

    if (IN(0)) {
        LAS float* scr = (LAS float*)(lds + RING_OFF + wave * 16384);
        convert_range<0>(a, ws, 0, CV_P0_END, gw, NGW, scr, lane);
        { f32x4 gv[16]; rms_gain_load(a.norm_mix, gv, lane);
          for (int m = gw; m < M; m += NGW) rms_row_bf16(m < MP ? a.xp + (size_t)m * D : a.xs + (size_t)(m - MP) * D, gv, ABUF + (size_t)m * D, lane); }
        for (int idx = blockIdx.x * (NWAVES * 64) + tid; idx < M * 8; idx += G * NWAVES * 64) { const int m = idx >> 3, i = idx & 7; const int pos = m < MP ? (m & 2047) : PAST + ((m - MP) & 7);
            const double c2p = i == 0 ? 0.15915494309189535 : i == 1 ? 0.03086376340470123 : i == 2 ? 0.005985185712713705 : i == 3 ? 0.001160663641240061 :
                               i == 4 ? 0.00022507907903927653 : i == 5 ? 4.364795279280289e-05 : i == 6 ? 8.464330808241401e-06 : 1.6414262627950345e-06;
            const double turns = (double)pos * c2p; const float fr = (float)(turns - floor(turns));
            ROPE[(size_t)m * 16 + i] = __builtin_amdgcn_cosf(fr); ROPE[(size_t)m * 16 + 8 + i] = __builtin_amdgcn_sinf(fr); }
        for (int i = blockIdx.x * (NWAVES * 64) + tid; i < BS * (WIN - TS) * (KVW / 4); i += G * NWAVES * 64) {
            const int c4 = i % (KVW / 4), br = i / (KVW / 4), r = br % (WIN - TS), b = br / (WIN - TS);
            ((f32x4*)(a.out + O_WK_S + ((size_t)b * WIN + r) * KVW))[c4] = ((const f32x4*)(a.cache_k + ((size_t)b * WIN + r + TS) * KVW))[c4];
            ((f32x4*)(a.out + O_WV_S + ((size_t)b * WIN + r) * KVW))[c4] = ((const f32x4*)(a.cache_v + ((size_t)b * WIN + r + TS) * KVW))[c4];
        }
    }
    SEAM(0);
    if (IN(1)) { pg8::Gemm g{ABUF, W_in, M, NPROJ, D, D}; pg8::StaticOrder S; S.init(M, NPROJ, G, (int)blockIdx.x); EpiProj E{PROJB, GR};
        pg8::gemm_phase<EpiProj, pg8::StaticOrder, true, true>(lds + RING_OFF, g, S, E);
        if ((int)blockIdx.x >= LEFT_P1) convert_range<CV_PACE>(a, ws, CV_P0_END, CV_P1_END, ((int)blockIdx.x - LEFT_P1) * NWAVES + wave, (G - LEFT_P1) * NWAVES, (LAS float*)(lds + RING_OFF + wave * 16384), lane); }
    SEAM(1);
    if (IN(2)) {
        for (int wu = MP * HA + gw; wu < M * HA; wu += NGW) {
            const int m = wu >> 5, h = wu & 31, b = (m - MP) >> 3, t = (m - MP) & 7;
            unsigned pw[3][4]; f32x2 sv[3][4], wv[3][4];
#pragma unroll
            for (int part = 0; part < 3; ++part) { const int c = part * 4096 + h * 128 + 2 * lane;
#pragma unroll
                for (int j = 0; j < 4; ++j) { const int tt = t - j;
                    pw[part][j] = *(const unsigned*)(PROJB + (size_t)(tt >= 0 ? m - j : m) * 16384 + c);
                    sv[part][j] = *(const f32x2*)(a.state_conv + ((size_t)b * 3 + (tt < 0 ? 3 + tt : 0)) * CCONV + c);
                    wv[part][j] = *(const f32x2*)(a.a_conv_w + (size_t)(3 - j) * CCONV + c); } }
            const float braw = GR[(size_t)m * 64 + h], araw = GR[(size_t)m * 64 + 32 + h] + a.a_dt_bias[h], alog = a.a_log[h];
            f32x2 res[3];
#pragma unroll
            for (int part = 0; part < 3; ++part) { f32x2 acc = {0.f, 0.f};
#pragma unroll
                for (int j = 0; j < 4; ++j) { const f32x2 xv = (t - j >= 0) ? (f32x2){__builtin_bit_cast(float, pw[part][j] << 16), __builtin_bit_cast(float, pw[part][j] & 0xffff0000u)} : sv[part][j]; acc += xv * wv[part][j]; }
                res[part].x = silu_acc(acc.x); res[part].y = silu_acc(acc.y); }
            const float sq = wave_sum(res[0].x * res[0].x + res[0].y * res[0].y), sk = wave_sum(res[1].x * res[1].x + res[1].y * res[1].y);
            const float rq = (1.0f / sqrtf(sq + EPS)) * 0.08838834764831845f, rk = 1.0f / sqrtf(sk + EPS);
            float* qo = QKVC + (size_t)m * CCONV + h * 128 + 2 * lane;
            *(f32x2*)qo = res[0] * rq; *(f32x2*)(qo + 4096) = res[1] * rk; *(f32x2*)(qo + 8192) = res[2];
            if (lane == 0) { const float sp = fmaxf(araw, 0.f) + log1pf(expf(-fabsf(araw)));
                GG[(size_t)m * HA + h] = -expf(alog) * sp; BETA[(size_t)m * HA + h] = 1.0f / (1.0f + expf(-braw)); }
        }
        for (int i = blockIdx.x * (NWAVES * 64) + tid; i < NSEQ * 3 * (CCONV / 4); i += G * NWAVES * 64) {
            const int c4 = i % (CCONV / 4), sr = i / (CCONV / 4), r = sr % 3, s = sr / 3;
            const int m = s < BP ? s * TP + (TP - 3) + r : MP + (s - BP) * TS + (TS - 3) + r;
            float* dst = s < BP ? a.out + O_CONV_P + ((size_t)s * 3 + r) * CCONV : a.out + O_CONV_S + ((size_t)(s - BP) * 3 + r) * CCONV;
            ((f32x4*)dst)[c4] = bf4_to_f32(((const v2u*)(PROJB + (size_t)m * 16384))[c4]);
        }
    }
    if (IN(3)) {
        {
            const int hb = wave >> 2, wh = wave & 3, th_o = tid & 255, lr_o = lane & 15, lq_o = lane >> 4;
            LAS unsigned char* hl = lds + RING_OFF + hb * PREP_HALF;
            LAS bf16* Kb = (LAS bf16*)hl;
            LAS bf16* Vb = (LAS bf16*)(hl + 17408);
            LAS bf16* Qb = (LAS bf16*)(hl + 34816);
            LAS float* Am = (LAS float*)(hl + 52224);
            LAS float* gcs = (LAS float*)(hl + 69632);
            const int nrep = (NCHUNK + 2 * G - 1) / (2 * G);
            v2u xraw[3][11];
#define PREP_FETCH(rep_, P0_, P1_) do { const int cu_ = (rep_) * 2 * G + blockIdx.x * 2 + hb, ci_ = cu_ < NCHUNK ? cu_ : 0, n_ = ci_ & 31, h_ = (ci_ >> 5) & 31, b_ = ci_ >> 10; \
                const bf16* pb_ = PROJB + (size_t)(b_ * TP + n_ * 64 + 8 * (th_o >> 5)) * 16384 + h_ * 128 + 4 * (th_o & 31); const int t0_ = n_ * 64 + 8 * (th_o >> 5); \
                _Pragma("unroll") for (int part = P0_; part < P1_; ++part) _Pragma("unroll") for (int k = 0; k < 11; ++k) \
                    xraw[part][k] = (t0_ + k - 3 >= 0) ? *(const v2u*)(pb_ + part * 4096 + (ptrdiff_t)(k - 3) * 16384) : (v2u){0u, 0u}; } while (0)
            PREP_FETCH(0, 0, 1);
            for (int rep = 0; rep < nrep; ++rep) {
                int th = th_o, lr = lr_o, lq = lq_o; asm volatile("" : "+v"(th), "+v"(lr), "+v"(lq));
                const int c4 = th & 31, rg = th >> 5;
                const int cu = rep * 2 * G + blockIdx.x * 2 + hb; const bool act = cu < NCHUNK; const int ci = act ? cu : 0;
                const int n = ci & 31, h = (ci >> 5) & 31, b = ci >> 10, m0 = b * TP + n * 64;
                float braw = 0.f, araw = 0.f; if (wh == 0) { const size_t mr = (size_t)(m0 + lane) * 64; braw = GR[mr + h]; araw = GR[mr + 32 + h]; }
                f32x4 qreg[8];
                { PREP_FETCH(rep, 1, 3);
#pragma unroll
                  for (int part = 0; part < 3; ++part) {
                      const float* cw = a.a_conv_w + part * 4096 + h * 128 + 4 * c4;
                      const f32x4 w0 = *(const f32x4*)cw, w1 = *(const f32x4*)(cw + CCONV), w2 = *(const f32x4*)(cw + 2 * CCONV), w3 = *(const f32x4*)(cw + 3 * CCONV);
                      f32x4 x[11];
#pragma unroll
                      for (int k = 0; k < 11; ++k) x[k] = bf4_to_f32(xraw[part][k]);
                      LAS bf16* tile = part == 0 ? Qb : (part == 1 ? Kb : Vb);
                      f32x4 y[8]; float ss[8];
#pragma unroll
                      for (int k = 0; k < 8; ++k) { y[k] = x[k] * w0 + x[k + 1] * w1 + x[k + 2] * w2 + x[k + 3] * w3;
                          y[k].x = pg8::silu_f(y[k].x); y[k].y = pg8::silu_f(y[k].y); y[k].z = pg8::silu_f(y[k].z); y[k].w = pg8::silu_f(y[k].w);
                          ss[k] = (y[k].x * y[k].x + y[k].y * y[k].y) + (y[k].z * y[k].z + y[k].w * y[k].w); }
                      if (part < 2) {
#pragma unroll
                          for (int o = 1; o < 32; o <<= 1) { float t[8];
#pragma unroll
                              for (int k = 0; k < 8; ++k) t[k] = __shfl_xor(ss[k], o);
#pragma unroll
                              for (int k = 0; k < 8; ++k) ss[k] += t[k]; }
#pragma unroll
                          for (int k = 0; k < 8; ++k) y[k] = y[k] * (__builtin_amdgcn_rsqf(ss[k] + EPS) * (part == 0 ? 0.08838834764831845f : 1.0f)); }
#pragma unroll
                      for (int k = 0; k < 8; ++k) { if (part == 0) qreg[k] = y[k];
                          v2u w; w.x = cvtpk_c(y[k].x, y[k].y); w.y = cvtpk_c(y[k].z, y[k].w); *(LAS v2u*)(tile + (8 * rg + k) * 136 + 4 * c4) = w; } } }
                if (wh == 0) { araw += a.a_dt_bias[h];
                    const float sp = fmaxf(araw, 0.f) + log1pf(expf(-fabsf(araw)));
                    float g = -expf(a.a_log[h]) * sp; const float bt = 1.0f / (1.0f + expf(-braw));
#pragma unroll
                    for (int o = 1; o < 64; o <<= 1) { const float tt = __shfl_up(g, o); if (lane >= o) g += tt; }
                    const float gl = __shfl(g, 63), eg = expf(g);
                    gcs[lane] = g; gcs[64 + lane] = bt * eg; gcs[128 + lane] = bt; gcs[192 + lane] = expf(gl - g); gcs[256 + lane] = eg; }
                LDS_BARRIER();
                if (act) {
#pragma unroll
                    for (int k = 0; k < 8; ++k) { const int i = 8 * rg + k; const f32x4 y = qreg[k] * gcs[256 + i]; v2u w; w.x = cvtpk_c(y.x, y.y); w.y = cvtpk_c(y.z, y.w);
                        *(v2u*)(QGb + (((size_t)ci * 4 + (i >> 4)) * 4 + (c4 >> 3)) * 512 + ((((c4 & 7) >> 1) * 16) + (i & 15)) * 8 + 4 * (c4 & 1)) = w; } }
                { pg8::bf16x8 bK[4], bQ[4];
#pragma unroll
                  for (int ks = 0; ks < 4; ++ks) { bK[ks] = *(const LAS pg8::bf16x8*)(Kb + (16 * wh + lr) * 136 + 32 * ks + 8 * lq); bQ[ks] = *(const LAS pg8::bf16x8*)(Qb + (16 * wh + lr) * 136 + 32 * ks + 8 * lq); }
                  const int i = 16 * wh + lr; const float gi = gcs[i], bi = gcs[128 + i];
#pragma unroll
                  for (int jt = 0; jt < 4; ++jt) {
                      f32x4 ck = {0.f, 0.f, 0.f, 0.f}, cq = {0.f, 0.f, 0.f, 0.f};
                      if (jt <= wh) {
#pragma unroll
                          for (int ks = 0; ks < 4; ++ks) { const pg8::bf16x8 aK = *(const LAS pg8::bf16x8*)(Kb + (16 * jt + lr) * 136 + 32 * ks + 8 * lq);
                              ck = __builtin_amdgcn_mfma_f32_16x16x32_bf16(aK, bK[ks], ck, 0, 0, 0); cq = __builtin_amdgcn_mfma_f32_16x16x32_bf16(aK, bQ[ks], cq, 0, 0, 0); } }
                      f32x4 av, qv;
#pragma unroll
                      for (int r = 0; r < 4; ++r) { const int j = 16 * jt + 4 * lq + r; const float dec = (i >= j) ? __expf(gi - gcs[j]) : 0.f;
                          av[r] = (i > j) ? ck[r] * dec * bi : 0.f; qv[r] = cq[r] * dec; }
                      *(LAS f32x4*)(Am + i * 68 + 16 * jt + 4 * lq) = av;
                      if (act) { v2u w; w.x = cvtpk_c(qv[0], qv[1]); w.y = cvtpk_c(qv[2], qv[3]); *(v2u*)(QKMb + (((size_t)ci * 4 + wh) * 2 + (jt >> 1)) * 512 + ((2 * (jt & 1) + (lq >> 1)) * 16 + lr) * 8 + 4 * (lq & 1)) = w; } } }
                float xr[64];
                { const LAS bf16* col = (wh < 2) ? Kb + th : Vb + (th - 128);
#pragma unroll
                  for (int i = 0; i < 64; ++i) xr[i] = __builtin_bit_cast(float, (unsigned)col[i * 136] << 16); }
                if (wh < 2) {
                    if (act) { bf16* kp = KDTb + ((size_t)ci * 8 + (th >> 4)) * 1024 + (th & 15) * 8;
#pragma unroll
                        for (int i8 = 0; i8 < 8; ++i8) { v4u w;
                            w.x = cvtpk_c(xr[8 * i8 + 0] * gcs[192 + 8 * i8 + 0], xr[8 * i8 + 1] * gcs[192 + 8 * i8 + 1]); w.y = cvtpk_c(xr[8 * i8 + 2] * gcs[192 + 8 * i8 + 2], xr[8 * i8 + 3] * gcs[192 + 8 * i8 + 3]);
                            w.z = cvtpk_c(xr[8 * i8 + 4] * gcs[192 + 8 * i8 + 4], xr[8 * i8 + 5] * gcs[192 + 8 * i8 + 5]); w.w = cvtpk_c(xr[8 * i8 + 6] * gcs[192 + 8 * i8 + 6], xr[8 * i8 + 7] * gcs[192 + 8 * i8 + 7]);
                            *(v4u*)(kp + (i8 >> 2) * 512 + (i8 & 3) * 128) = w; } }
#pragma unroll
                    for (int i = 0; i < 64; ++i) xr[i] *= gcs[64 + i];
                } else {
#pragma unroll
                    for (int i = 0; i < 64; ++i) xr[i] *= gcs[128 + i];
                }
                LDS_BARRIER();
                { LAS bf16* Xs = Kb; LAS bf16* Ab = (LAS bf16*)(hl + 34816 + 2048); LAS float* Dg = (LAS float*)(hl + 34816 + 2048 + 9216); LAS float* Cs = Am;
#pragma unroll
                  for (int k = 0; k < 4; ++k) { const int e4 = th + 256 * k, i = e4 >> 4, j4 = (e4 & 15) * 4; const f32x4 a4 = *(const LAS f32x4*)(Am + i * 68 + j4);
                      const bool below = (j4 >> 4) < (i >> 4); v2u w; w.x = below ? cvtpk_c(a4.x, a4.y) : 0u; w.y = below ? cvtpk_c(a4.z, a4.w) : 0u; *(LAS v2u*)(Ab + i * 72 + j4) = w;
                      if ((j4 >> 4) == (i >> 4)) *(LAS f32x4*)(Dg + ((i >> 4) * 16 + (i & 15)) * 20 + (j4 & 15)) = a4; }
#pragma unroll
                  for (int k = 0; k < 9; ++k) *(LAS v4u*)(Xs + 8 * (th + 256 * k)) = (v4u){0u, 0u, 0u, 0u};
                  LDS_BARRIER();
#pragma unroll
                  for (int bi = 0; bi < 4; ++bi) {
                      if (bi > 0) {
                          f32x4 cacc[4]; pg8::bf16x8 aA[2], bX[4][2];
#pragma unroll
                          for (int ks = 0; ks < (bi == 3 ? 2 : 1); ++ks) { aA[ks] = *(const LAS pg8::bf16x8*)(Ab + (16 * bi + lr) * 72 + 32 * ks + 8 * lq);
#pragma unroll
                              for (int t4 = 0; t4 < 4; ++t4) bX[t4][ks] = *(const LAS pg8::bf16x8*)(Xs + (16 * (4 * wh + t4) + lr) * 72 + 32 * ks + 8 * lq); }
                          __builtin_amdgcn_sched_barrier(0);
#pragma unroll
                          for (int t4 = 0; t4 < 4; ++t4) { cacc[t4] = (f32x4){0.f, 0.f, 0.f, 0.f};
#pragma unroll
                              for (int ks = 0; ks < (bi == 3 ? 2 : 1); ++ks) cacc[t4] = __builtin_amdgcn_mfma_f32_16x16x32_bf16(aA[ks], bX[t4][ks], cacc[t4], 0, 0, 0); }
#pragma unroll
                          for (int t4 = 0; t4 < 4; ++t4)
#pragma unroll
                              for (int r = 0; r < 4; ++r) Cs[(16 * (4 * wh + t4) + lr) * 17 + 4 * lq + r] = cacc[t4][r];
                          LDS_BARRIER();
#pragma unroll
                          for (int r = 0; r < 16; ++r) xr[16 * bi + r] -= Cs[th * 17 + r];
                      }
#pragma unroll
                      for (int row = 1; row < 16; ++row) { float t = xr[16 * bi + row];
#pragma unroll
                          for (int q = 0; q <= (row - 1) / 4; ++q) { const f32x4 d4 = *(const LAS f32x4*)(Dg + (bi * 16 + row) * 20 + 4 * q);
                              if (4 * q + 0 < row) t -= d4.x * xr[16 * bi + 4 * q + 0];
                              if (4 * q + 1 < row) t -= d4.y * xr[16 * bi + 4 * q + 1];
                              if (4 * q + 2 < row) t -= d4.z * xr[16 * bi + 4 * q + 2];
                              if (4 * q + 3 < row) t -= d4.w * xr[16 * bi + 4 * q + 3]; }
                          xr[16 * bi + row] = t; }
                      {
                          v4u x0, x1;
                          x0.x = cvtpk_c(xr[16 * bi + 0], xr[16 * bi + 1]); x0.y = cvtpk_c(xr[16 * bi + 2], xr[16 * bi + 3]); x0.z = cvtpk_c(xr[16 * bi + 4], xr[16 * bi + 5]); x0.w = cvtpk_c(xr[16 * bi + 6], xr[16 * bi + 7]);
                          x1.x = cvtpk_c(xr[16 * bi + 8], xr[16 * bi + 9]); x1.y = cvtpk_c(xr[16 * bi + 10], xr[16 * bi + 11]); x1.z = cvtpk_c(xr[16 * bi + 12], xr[16 * bi + 13]); x1.w = cvtpk_c(xr[16 * bi + 14], xr[16 * bi + 15]);
                          *(LAS v4u*)(Xs + th * 72 + 16 * bi) = x0; *(LAS v4u*)(Xs + th * 72 + 16 * bi + 8) = x1;
                          LDS_BARRIER(); } } }
                if (rep + 1 < nrep) PREP_FETCH(rep + 1, 0, 1);
                if (act) { const LAS bf16* Xs = Kb;
#pragma unroll
                    for (int k = 0; k < 4; ++k) { const int wks = 4 * k + (th >> 6), w_ = wks >> 2, ks = wks & 3, ls = th & 63, lrs = ls & 15, lqs = ls >> 4;
                        const LAS bf16* xp = Xs + (32 * ks + 8 * lqs) * 72 + 16 * w_ + lrs; v4u o;
                        o.x = ((unsigned)xp[0 * 72] | ((unsigned)xp[1 * 72] << 16)) ^ 0x80008000u; o.y = ((unsigned)xp[2 * 72] | ((unsigned)xp[3 * 72] << 16)) ^ 0x80008000u;
                        o.z = ((unsigned)xp[4 * 72] | ((unsigned)xp[5 * 72] << 16)) ^ 0x80008000u; o.w = ((unsigned)xp[6 * 72] | ((unsigned)xp[7 * 72] << 16)) ^ 0x80008000u;
                        *(v4u*)(WMb + (((size_t)ci * 4 + w_) * 4 + ks) * 512 + ls * 8) = o; }
#pragma unroll
                    for (int k = 0; k < 2; ++k) { const int slot = th + 256 * k, ls = slot & 63, ws_ = (slot >> 6) & 3, hs = slot >> 8, lrs = ls & 15, lqs = ls >> 4;
                        v2u t4[4];
#pragma unroll
                        for (int ct = 0; ct < 4; ++ct) t4[ct] = *(const LAS v2u*)(Xs + (128 + 64 * hs + 16 * ct + lrs) * 72 + 16 * ws_ + 4 * lqs);
                        v4u* up = (v4u*)(U0c + ((((size_t)ci * 2 + hs) * 4 + ws_) * 64 + ls) * 16);
                        v4u u0, u1; u0.x = t4[0].x; u0.y = t4[0].y; u0.z = t4[1].x; u0.w = t4[1].y; u1.x = t4[2].x; u1.y = t4[2].y; u1.z = t4[3].x; u1.w = t4[3].y; up[0] = u0; up[1] = u1; }
                    if (th == 0) EGLb[ci] = gcs[256 + 63];
                }
                LDS_BARRIER();
            }
        }
        xcd_barrier(bar);
        for (int un = gw; un < BS * HA * 8; un += NGW) {
            const int s = un / 256, h = (un >> 3) & 31, cg = un & 7;
            const int m0 = MP + s * TS;
            const int e = cg * 16 + (lane & 15), dg = lane >> 4;
            float hst[32];
            { const float* hp = a.state_ssm + (((size_t)s * HA + h) * DKA + dg * 32) * 128 + e;
#pragma unroll
              for (int i = 0; i < 32; ++i) hst[i] = hp[(size_t)i * 128]; }
            f32x4 kc[8], qc[8], kn[8], qn[8]; float vc, gc, bc, vn = 0.f, gn = 0.f, bn = 0.f;
            { const float* rp = QKVC + (size_t)m0 * CCONV + h * 128;
#pragma unroll
              for (int i = 0; i < 8; ++i) { qc[i] = *(const f32x4*)(rp + dg * 32 + 4 * i); kc[i] = *(const f32x4*)(rp + 4096 + dg * 32 + 4 * i); }
              vc = rp[8192 + e]; gc = GG[(size_t)m0 * HA + h]; bc = BETA[(size_t)m0 * HA + h]; }
#pragma unroll 1
            for (int t = 0; t < TS; ++t) {
                const int m = m0 + t;
                if (t + 1 < TS) { const float* rp = QKVC + (size_t)(m + 1) * CCONV + h * 128;
#pragma unroll
                    for (int i = 0; i < 8; ++i) { qn[i] = *(const f32x4*)(rp + dg * 32 + 4 * i); kn[i] = *(const f32x4*)(rp + 4096 + dg * 32 + 4 * i); }
                    vn = rp[8192 + e]; gn = GG[(size_t)(m + 1) * HA + h]; bn = BETA[(size_t)(m + 1) * HA + h]; }
                const float decay = expf(gc);
                float p0 = 0.f, p1 = 0.f, p2 = 0.f, p3 = 0.f;
#pragma unroll
                for (int i = 0; i < 8; ++i) { p0 += kc[i].x * hst[4 * i]; p1 += kc[i].y * hst[4 * i + 1]; p2 += kc[i].z * hst[4 * i + 2]; p3 += kc[i].w * hst[4 * i + 3]; }
                float kh = (p0 + p1) + (p2 + p3); kh += __shfl_xor(kh, 16); kh += __shfl_xor(kh, 32);
                const float u = bc * (vc - decay * kh);
                p0 = 0.f; p1 = 0.f; p2 = 0.f; p3 = 0.f;
#pragma unroll
                for (int i = 0; i < 8; ++i) {
                    hst[4 * i] = decay * hst[4 * i] + kc[i].x * u; hst[4 * i + 1] = decay * hst[4 * i + 1] + kc[i].y * u; hst[4 * i + 2] = decay * hst[4 * i + 2] + kc[i].z * u; hst[4 * i + 3] = decay * hst[4 * i + 3] + kc[i].w * u;
                    p0 += qc[i].x * hst[4 * i]; p1 += qc[i].y * hst[4 * i + 1]; p2 += qc[i].z * hst[4 * i + 2]; p3 += qc[i].w * hst[4 * i + 3]; }
                float o = (p0 + p1) + (p2 + p3); o += __shfl_xor(o, 16); o += __shfl_xor(o, 32);
                if (dg == 0) OB[(size_t)m * D + h * 128 + e] = (bf16)f2bf(o);
#pragma unroll
                for (int i = 0; i < 8; ++i) { kc[i] = kn[i]; qc[i] = qn[i]; }
                vc = vn; gc = gn; bc = bn;
            }
            float* hp = a.out + O_SSM_S + (((size_t)s * HA + h) * DKA + dg * 32) * 128 + e;
#pragma unroll
            for (int i = 0; i < 32; ++i) hp[(size_t)i * 128] = hst[i];
        }
        {
            LAS bf16* Ht = (LAS bf16*)(lds + RING_OFF);
            LAS bf16* Ut = (LAS bf16*)(lds + RING_OFF + 17408);
            const int lr = lane & 15, lq = lane >> 4, w = wave;
            for (int un = blockIdx.x; un < BP * HA * 2; un += G) {
                const int b = un >> 6, h = (un >> 1) & 31, e0 = 64 * (un & 1);
                __syncthreads();
                for (int i = tid; i < 64 * 136 / 2; i += NWAVES * 64) ((LAS unsigned*)Ht)[i] = 0u;
                f32x4 Hacc[4];
#pragma unroll
                for (int ct = 0; ct < 4; ++ct) Hacc[ct] = (f32x4){0.f, 0.f, 0.f, 0.f};
                __syncthreads();
                const size_t cb = ((size_t)(b * HA + h)) * 32;
                v4u AF[4], AKD[2], AX0, AX1, BF[4], BKD[2], BX0, BX1, CF[4], CKD[2], CX0, CX1; float AE, BE, CE;
#define SCAN_LOAD(S, ci) do { const size_t _ci = (ci); \
                    const bf16* _rf = (w < 4 ? WMb : QGb) + (_ci * 4 + (w & 3)) * 2048 + lane * 8; const int _fs = 512; \
                    _Pragma("unroll") for (int ks = 0; ks < 4; ++ks) S##F[ks] = *(const v4u*)(_rf + _fs * ks); \
                    const bf16* _rk = KDTb + (_ci * 8 + w) * 1024 + lane * 8; S##KD[0] = *(const v4u*)_rk; S##KD[1] = *(const v4u*)(_rk + 512); \
                    const bf16* _rx = (w < 4) ? U0c + (((_ci * 2 + (e0 >> 6)) * 4 + w) * 64 + lane) * 16 : QKMb + (_ci * 4 + (w - 4)) * 1024 + lane * 8; \
                    S##X0 = *(const v4u*)_rx; S##X1 = *(const v4u*)(_rx + (w < 4 ? 8 : 512)); S##E = EGLb[_ci]; } while (0)
#define BF2F_LO(u) __builtin_bit_cast(float, (u) << 16)
#define BF2F_HI(u) __builtin_bit_cast(float, (u) & 0xffff0000u)
#define SCAN_STEP(S, nn) do { const int n_ = (nn); f32x4 acc[4]; \
                    if (w < 4) { acc[0] = (f32x4){BF2F_LO(S##X0.x), BF2F_HI(S##X0.x), BF2F_LO(S##X0.y), BF2F_HI(S##X0.y)}; acc[1] = (f32x4){BF2F_LO(S##X0.z), BF2F_HI(S##X0.z), BF2F_LO(S##X0.w), BF2F_HI(S##X0.w)}; \
                                 acc[2] = (f32x4){BF2F_LO(S##X1.x), BF2F_HI(S##X1.x), BF2F_LO(S##X1.y), BF2F_HI(S##X1.y)}; acc[3] = (f32x4){BF2F_LO(S##X1.z), BF2F_HI(S##X1.z), BF2F_LO(S##X1.w), BF2F_HI(S##X1.w)}; } \
                    else { _Pragma("unroll") for (int ct = 0; ct < 4; ++ct) acc[ct] = (f32x4){0.f, 0.f, 0.f, 0.f}; } \
                    _Pragma("unroll") for (int c2 = 0; c2 < 2; ++c2) { pg8::bf16x8 bH[2][4]; \
                      _Pragma("unroll") for (int ct = 0; ct < 2; ++ct) _Pragma("unroll") for (int ks = 0; ks < 4; ++ks) bH[ct][ks] = *(const LAS pg8::bf16x8*)(Ht + (16 * (2 * c2 + ct) + lr) * 136 + 32 * ks + 8 * lq); \
                      __builtin_amdgcn_sched_barrier(0); \
                      _Pragma("unroll") for (int ks = 0; ks < 4; ++ks) _Pragma("unroll") for (int ct = 0; ct < 2; ++ct) \
                            acc[2 * c2 + ct] = __builtin_amdgcn_mfma_f32_16x16x32_bf16(__builtin_bit_cast(pg8::bf16x8, S##F[ks]), bH[ct][ks], acc[2 * c2 + ct], 0, 0, 0); \
                      __builtin_amdgcn_sched_barrier(0); } \
                    if (w < 4) { \
                        _Pragma("unroll") for (int ct = 0; ct < 4; ++ct) { v2u uw; uw.x = cvtpk_c(acc[ct][0], acc[ct][1]); uw.y = cvtpk_c(acc[ct][2], acc[ct][3]); \
                            *(LAS v2u*)(Ut + (16 * ct + lr) * 72 + 16 * w + 4 * lq) = uw; } } \
                    LDS_BARRIER(); \
                    const int m0 = b * TP + n_ * 64; \
                    pg8::bf16x8 bU[4][2]; \
                    _Pragma("unroll") for (int ct = 0; ct < 4; ++ct) _Pragma("unroll") for (int k2 = 0; k2 < 2; ++k2) bU[ct][k2] = *(const LAS pg8::bf16x8*)(Ut + (16 * ct + lr) * 72 + 32 * k2 + 8 * lq); \
                    __builtin_amdgcn_sched_barrier(0); \
                    _Pragma("unroll") for (int ct = 0; ct < 4; ++ct) { Hacc[ct] = Hacc[ct] * S##E; \
                        _Pragma("unroll") for (int k2 = 0; k2 < 2; ++k2) { \
                            Hacc[ct] = __builtin_amdgcn_mfma_f32_16x16x32_bf16(__builtin_bit_cast(pg8::bf16x8, S##KD[k2]), bU[ct][k2], Hacc[ct], 0, 0, 0); \
                            if (w >= 4) acc[ct] = __builtin_amdgcn_mfma_f32_16x16x32_bf16(__builtin_bit_cast(pg8::bf16x8, k2 ? S##X1 : S##X0), bU[ct][k2], acc[ct], 0, 0, 0); } \
                        v2u hw; hw.x = cvtpk_c(Hacc[ct][0], Hacc[ct][1]); hw.y = cvtpk_c(Hacc[ct][2], Hacc[ct][3]); \
                        *(LAS v2u*)(Ht + (16 * ct + lr) * 136 + 16 * w + 4 * lq) = hw; \
                        if (w >= 4) { \
                            const unsigned o01 = cvtpk_c(acc[ct][0], acc[ct][1]), o23 = cvtpk_c(acc[ct][2], acc[ct][3]); bf16* op = OB + (size_t)(m0 + 16 * (w - 4) + 4 * lq) * D + h * 128 + e0 + 16 * ct + lr; \
                            op[0] = (bf16)o01; op[D] = (bf16)(o01 >> 16); op[2 * D] = (bf16)o23; op[3 * D] = (bf16)(o23 >> 16); } } \
                    LDS_BARRIER(); \
                    if (n_ + 3 < 32) SCAN_LOAD(S, cb + n_ + 3); } while (0)
                SCAN_LOAD(A, cb); SCAN_LOAD(B, cb + 1); SCAN_LOAD(C, cb + 2);
                for (int n = 0; n < 30; n += 3) { SCAN_STEP(A, n); SCAN_STEP(B, n + 1); SCAN_STEP(C, n + 2); }
                SCAN_STEP(A, 30); SCAN_STEP(B, 31);
#undef SCAN_STEP
#undef SCAN_LOAD
#pragma unroll
                for (int ct = 0; ct < 4; ++ct)
#pragma unroll
                    for (int r = 0; r < 4; ++r) a.out[O_SSM_P + (((size_t)(b * HA + h)) * DKA + 16 * w + 4 * lq + r) * 128 + e0 + 16 * ct + lr] = Hacc[ct][r];
            }
            __syncthreads();
        }
    }
    SEAM(3);
    if (IN(4)) {
        { const int c = 4 * (lane & 31); const f32x4 w4 = *(const f32x4*)(a.a_o_norm + c);
          for (int wu0 = gw; wu0 < M * HA / 2; wu0 += 8 * NGW) {
              f32x4 o4[8]; v2u zr[8];
#pragma unroll
              for (int k = 0; k < 8; ++k) { const int wu = wu0 + k * NGW; if (wu < M * HA / 2) { const int mh = 2 * wu + (lane >> 5), m = mh >> 5, h = mh & 31;
                      o4[k] = bf4_to_f32(*(const v2u*)(OB + (size_t)m * D + h * 128 + c)); zr[k] = *(const v2u*)(PROJB + (size_t)m * 16384 + CCONV + h * 128 + c); } else { o4[k] = (f32x4){0.f, 0.f, 0.f, 0.f}; zr[k] = (v2u){0u, 0u}; } }
              float ss[8];
#pragma unroll
              for (int k = 0; k < 8; ++k) ss[k] = (o4[k].x * o4[k].x + o4[k].y * o4[k].y) + (o4[k].z * o4[k].z + o4[k].w * o4[k].w);
#pragma unroll
              for (int o = 1; o < 32; o <<= 1) { float t[8];
#pragma unroll
                  for (int k = 0; k < 8; ++k) t[k] = __shfl_xor(ss[k], o);
#pragma unroll
                  for (int k = 0; k < 8; ++k) ss[k] += t[k]; }
#pragma unroll
              for (int k = 0; k < 8; ++k) { const int wu = wu0 + k * NGW; if (wu < M * HA / 2) { const int mh = 2 * wu + (lane >> 5), m = mh >> 5, h = mh & 31;
                      const float r = 1.0f / sqrtf(ss[k] * (1.0f / 128.0f) + EPS); const f32x4 z4 = bf4_to_f32(zr[k]);
                      v2u ow; ow.x = pk2(o4[k].x * r * w4.x * pg8::silu_f(z4.x), o4[k].y * r * w4.y * pg8::silu_f(z4.y)); ow.y = pk2(o4[k].z * r * w4.z * pg8::silu_f(z4.z), o4[k].w * r * w4.w * pg8::silu_f(z4.w));
                      *(v2u*)(ABUF + (size_t)m * D + h * 128 + c) = ow; } } } }
        for (int i = blockIdx.x * (NWAVES * 64) + tid; i < MS * D / 4; i += G * NWAVES * 64) ((f32x4*)(Hres + (size_t)MP * D))[i] = ((const f32x4*)a.xs)[i];
    }
    SEAM(4);
#define GEMM_N4096(Aop, Wt, KK, INF_, OUTF_, BASEF) do { \
    { pg8::Gemm g{Aop, Wt, MP, D, KK, KK}; pg8::StaticOrder S; S.init(MP, D, G, (int)blockIdx.x); pg8::EpiResT<INF_, OUTF_> E{BASEF, Hres, HB16, D}; \
      pg8::gemm_phase<pg8::EpiResT<INF_, OUTF_>, pg8::StaticOrder, true, true>(lds + RING_OFF, g, S, E); } \
    { const int sp = 2 * ((int)blockIdx.x & 7) + (((int)blockIdx.x >> 3) & 1), pn = (int)blockIdx.x >> 4;     \
      const int k0 = (KK == D) ? 256 * sp : (sp < 6 ? 768 * sp : 4608 + 640 * (sp - 6)), kl = (KK == D) ? 256 : (sp < 6 ? 768 : 640); \
      pg8::Gemm g{Aop + (size_t)MP * KK + k0, Wt + k0, MS, D, kl, KK}; pg8::OneUnit S{0, pn}; EpiSlab E{SLAB + (size_t)sp * MS * D, D}; \
      pg8::gemm_phase<EpiSlab, pg8::OneUnit, false, true>(lds + RING_OFF, g, S, E); } } while (0)
    if (IN(5)) GEMM_N4096(ABUF, W_out, D, true, false, a.xp);
    SEAM(5);
    if (IN(6)) norm_phase(Hres, HB16, a.norm_ffn, ABUF, SLAB, (LAS float*)(lds + RING_OFF), G, gw, NGW, lane, wave);
    SEAM(6);
    if (IN(7)) { pg8::Gemm g{ABUF, (const bf16*)(ws + WS_WGU0), M, NGU, D, D}; pg8::StaticOrder S; S.init(M, NGU, G, (int)blockIdx.x); pg8::EpiSwiGLU E{ACT, DFF};
        pg8::gemm_phase<pg8::EpiSwiGLU, pg8::StaticOrder, true, true>(lds + RING_OFF, g, S, E);
        if ((int)blockIdx.x >= LEFT_GU) convert_range<CV_PACE>(a, ws, CV_P1_END, CV_P7_END, ((int)blockIdx.x - LEFT_GU) * NWAVES + wave, (G - LEFT_GU) * NWAVES, (LAS float*)(lds + RING_OFF + wave * 16384), lane); }
    SEAM(7);
    if (IN(8)) GEMM_N4096(ACT, (const bf16*)(ws + WS_WDN0), DFF, false, false, (const float*)nullptr);
    SEAM(8);
    if (IN(9)) norm_phase(Hres, HB16, nullptr, ABUF, SLAB, (LAS float*)(lds + RING_OFF), G, gw, NGW, lane, wave);
    SEAM(9);
    if (IN(10)) { pg8::Gemm g{ABUF, W_kvq, M, NKVQ, D, D}; pg8::StaticOrder S; S.init(M, NKVQ, G, (int)blockIdx.x); EpiKVQ E{KN, VN, QB, ROPE, a.k_norm, a.b_q_norm, a.out};
        pg8::gemm_phase<EpiKVQ, pg8::StaticOrder, true, true>(lds + RING_OFF, g, S, E);
        if ((int)blockIdx.x >= LEFT_KVQ) convert_range<CV_PACE>(a, ws, CV_P7_END, CV_P10_END, ((int)blockIdx.x - LEFT_KVQ) * NWAVES + wave, (G - LEFT_KVQ) * NWAVES, (LAS float*)(lds + RING_OFF + wave * 16384), lane); }
    SEAM(10);
    if (IN(12)) {
        LAS bf16* Kt = (LAS bf16*)(lds + RING_OFF);
        LAS bf16* Vt = (LAS bf16*)(lds + RING_OFF + 208 * 144);
        const int lr = lane & 15, lq = lane >> 4;
        constexpr int NU = BP * KVH * (TP / 64) + BS * KVH;
        static_assert(NU == ATT_UNITS_PER_WG * 256, "every workgroup runs the same number of attention units (the conversion items beside them are counted per unit)");
        LAS float* cscr = (LAS float*)(lds + RING_OFF + 65536 + wave * 8448); int cvk = 0;
        for (int un = blockIdx.x; un < NU; un += G) {
            bool samp; int b, kvh, q0;
            if (un < BP * KVH * (TP / 64)) { samp = false; b = un / (KVH * (TP / 64)); const int r = un % (KVH * (TP / 64)); kvh = r / (TP / 64); q0 = (r % (TP / 64)) * 64; }
            else { samp = true; const int r = un - BP * KVH * (TP / 64); b = r / KVH; kvh = r % KVH; q0 = WIN; }
            const int cvit = CV_P10_END + cvk * CV_N12 * NGW + gw; ++cvk;
            const CvItem cqa = cv_decode(a, ws, cvit); f32x4 cva[8]; cv_load(cqa, cva, lane);
            f32x4 kq[7], vq[7];
            auto tile_src = [&](const float* N, const float* cache, int kp, bool inr, bool& ok) -> const float* {
                const int kc = kp < 0 ? 0 : kp;
                const float* p = !samp ? N + ((size_t)(b * TP + kc)) * KVW : (kc < WIN ? cache + ((size_t)b * WIN + kc) * KVW : N + ((size_t)(MP + b * TS + (kc - WIN))) * KVW);
                ok = inr && (!samp ? (kp >= 0 && kp < TP) : (kp < WIN + TS));
                return (ok ? p : N) + kvh * 64; };
#pragma unroll
            for (int it = 0; it < 7; ++it) { const int i = tid + NWAVES * 64 * it; bool ok;
                { const int j = i >> 4, c4 = i & 15; const float* p = tile_src(KN, a.cache_k, q0 - WIN + j, i < 208 * 16, ok); kq[it] = ((const f32x4*)p)[c4]; }
                { const int c4 = i / 208, j = i - c4 * 208; const float* p = tile_src(VN, a.cache_v, q0 - WIN + j, i < 208 * 16, ok); vq[it] = ((const f32x4*)p)[c4 & 15]; } }
            __syncthreads();
#pragma unroll
            for (int it = 0; it < 7; ++it) { const int i = tid + NWAVES * 64 * it;
                if (i < 208 * 16) { bool ok;
                    { const int j = i >> 4, c4 = i & 15; (void)tile_src(KN, a.cache_k, q0 - WIN + j, true, ok); const f32x4 kv = ok ? kq[it] : (f32x4){0.f, 0.f, 0.f, 0.f};
                      v2u kw; kw.x = cvtpk_c(kv.x, kv.y); kw.y = cvtpk_c(kv.z, kv.w); *(LAS v2u*)(Kt + j * 72 + 4 * c4) = kw; }
                    { const int c4 = i / 208, j = i - c4 * 208; (void)tile_src(VN, a.cache_v, q0 - WIN + j, true, ok); const f32x4 vv = ok ? vq[it] : (f32x4){0.f, 0.f, 0.f, 0.f};
                      Vt[(4 * c4 + 0) * 216 + j] = (bf16)f2bf(vv.x); Vt[(4 * c4 + 1) * 216 + j] = (bf16)f2bf(vv.y); Vt[(4 * c4 + 2) * 216 + j] = (bf16)f2bf(vv.z); Vt[(4 * c4 + 3) * 216 + j] = (bf16)f2bf(vv.w); } } }
            __syncthreads();
            cv_store(cqa, cva, cscr, lane);
            const CvItem cqb = cv_decode(a, ws, cvit + NGW); f32x4 cvb[8]; cv_load(cqb, cvb, lane);
            const int qh = kvh * 8 + wave; const float sink = a.b_sinks[qh];
            const int nqs = samp ? 1 : 4;
            for (int qs = 0; qs < nqs; ++qs) {
                const bool valid = samp ? lr < TS : true;
                const int mq = samp ? MP + b * TS + (lr & 7) : b * TP + q0 + 16 * qs + lr;
                pg8::bf16x8 bQ[2];
#pragma unroll
                for (int ks = 0; ks < 2; ++ks) bQ[ks] = *(const pg8::bf16x8*)(QB + (size_t)mq * D + qh * 64 + 32 * ks + 8 * lq);
                f32x4 sT[10];
#pragma unroll
                for (int j5 = 0; j5 < 2; ++j5) { pg8::bf16x8 aK[5][2];
#pragma unroll
                    for (int jj = 0; jj < 5; ++jj)
#pragma unroll
                        for (int ks = 0; ks < 2; ++ks) aK[jj][ks] = *(const LAS pg8::bf16x8*)(Kt + (16 * (qs + 5 * j5 + jj) + lr) * 72 + 32 * ks + 8 * lq);
                    __builtin_amdgcn_sched_barrier(0);
#pragma unroll
                    for (int jj = 0; jj < 5; ++jj) { sT[5 * j5 + jj] = (f32x4){0.f, 0.f, 0.f, 0.f};
#pragma unroll
                        for (int ks = 0; ks < 2; ++ks) sT[5 * j5 + jj] = __builtin_amdgcn_mfma_f32_16x16x32_bf16(aK[jj][ks], bQ[ks], sT[5 * j5 + jj], 0, 0, 0); }
                    __builtin_amdgcn_sched_barrier(0); }
                float mx = sink;
#pragma unroll
                for (int jt = 0; jt < 10; ++jt)
#pragma unroll
                    for (int r = 0; r < 4; ++r) { const int dpos = WIN + lr - 16 * jt - 4 * lq - r, kp = q0 - WIN + 16 * (qs + jt) + 4 * lq + r;
                        const bool ok = dpos >= 0 && dpos < WIN && kp >= 0;
                        sT[jt][r] = ok ? sT[jt][r] : -INFINITY; mx = fmaxf(mx, sT[jt][r]); }
                mx = fmaxf(mx, __shfl_xor(mx, 16)); mx = fmaxf(mx, __shfl_xor(mx, 32));
                float l = 0.f;
#pragma unroll
                for (int jt = 0; jt < 10; ++jt)
#pragma unroll
                    for (int r = 0; r < 4; ++r) { sT[jt][r] = __expf(sT[jt][r] - mx); l += sT[jt][r]; }
                l += __shfl_xor(l, 16); l += __shfl_xor(l, 32); l += __expf(sink - mx);
                f32x4 oT[4];
#pragma unroll
                for (int dt = 0; dt < 4; ++dt) oT[dt] = (f32x4){0.f, 0.f, 0.f, 0.f};
#pragma unroll
                for (int kk = 0; kk < 5; ++kk) {
                    v4u pw; pw.x = cvtpk_c(sT[2 * kk][0], sT[2 * kk][1]); pw.y = cvtpk_c(sT[2 * kk][2], sT[2 * kk][3]); pw.z = cvtpk_c(sT[2 * kk + 1][0], sT[2 * kk + 1][1]); pw.w = cvtpk_c(sT[2 * kk + 1][2], sT[2 * kk + 1][3]);
                    const pg8::bf16x8 bP = __builtin_bit_cast(pg8::bf16x8, pw);
                    v4u vw[4];
#pragma unroll
                    for (int dt = 0; dt < 4; ++dt) { const v2u v0 = *(const LAS v2u*)(Vt + (16 * dt + lr) * 216 + 16 * (qs + 2 * kk) + 4 * lq), v1 = *(const LAS v2u*)(Vt + (16 * dt + lr) * 216 + 16 * (qs + 2 * kk + 1) + 4 * lq);
                        vw[dt].x = v0.x; vw[dt].y = v0.y; vw[dt].z = v1.x; vw[dt].w = v1.y; }
                    __builtin_amdgcn_sched_barrier(0);
#pragma unroll
                    for (int dt = 0; dt < 4; ++dt) oT[dt] = __builtin_amdgcn_mfma_f32_16x16x32_bf16(__builtin_bit_cast(pg8::bf16x8, vw[dt]), bP, oT[dt], 0, 0, 0);
                    __builtin_amdgcn_sched_barrier(0); }
                if (valid) { const float inv = 1.0f / l;
#pragma unroll
                    for (int dt = 0; dt < 4; ++dt) { v2u ow; ow.x = cvtpk_c(oT[dt][0] * inv, oT[dt][1] * inv); ow.y = cvtpk_c(oT[dt][2] * inv, oT[dt][3] * inv);
                        *(v2u*)(ABUF + (size_t)mq * D + qh * 64 + 16 * dt + 4 * lq) = ow; } }
            }
            cv_store(cqb, cvb, cscr, lane);
        }
        __syncthreads();
    }
    SEAM(12);
    if (IN(13)) GEMM_N4096(ABUF, W_o, D, false, false, (const float*)nullptr);
    SEAM(13);
    if (IN(14)) norm_phase(Hres, HB16, a.norm_ffn + D, ABUF, SLAB, (LAS float*)(lds + RING_OFF), G, gw, NGW, lane, wave);
    SEAM(14);
    if (IN(15)) { pg8::Gemm g{ABUF, (const bf16*)(ws + WS_WGU1), M, NGU, D, D}; pg8::StaticOrder S; S.init(M, NGU, G, (int)blockIdx.x); pg8::EpiSwiGLU E{ACT, DFF};
        pg8::gemm_phase<pg8::EpiSwiGLU, pg8::StaticOrder, true, true>(lds + RING_OFF, g, S, E);
        if ((int)blockIdx.x >= LEFT_GU) convert_range<CV_PACE>(a, ws, CV_P12_END, CV_E_DN1, ((int)blockIdx.x - LEFT_GU) * NWAVES + wave, (G - LEFT_GU) * NWAVES, (LAS float*)(lds + RING_OFF + wave * 16384), lane); }
    SEAM(15);
    if (IN(16)) GEMM_N4096(ACT, (const bf16*)(ws + WS_WDN1), DFF, false, true, (const float*)nullptr);
    SEAM(16);
    if (IN(17)) {
        for (int r = blockIdx.x; r < MS; r += G) { const size_t ro = (size_t)(MP + r) * D + 4 * tid;
            f32x4 v0 = *(const f32x4*)(Hres + ro), v1 = *(const f32x4*)(Hres + ro + 2048); f32x4 p0[16], p1[16];
#pragma unroll
            for (int sp = 0; sp < 16; ++sp) { const bf16* q = SLAB + ((size_t)sp * MS + r) * D + 4 * tid; p0[sp] = bf4_to_f32(*(const v2u*)q); p1[sp] = bf4_to_f32(*(const v2u*)(q + 2048)); }
#pragma unroll
            for (int sp = 0; sp < 16; ++sp) { v0 += p0[sp]; v1 += p1[sp]; }
            *(f32x4*)(Hres + ro) = v0; *(f32x4*)(Hres + ro + 2048) = v1; }
    }
#undef IN
#undef SEAM
}

constexpr int NPHASES = 18;
extern "C" void kernel_launch(void* const* d_in, const int* in_sizes, int n_in, void* d_out, int out_size, void* d_ws, size_t ws_size, hipStream_t stream) {
    static int grid = 0;
    if (grid == 0) {
        if (n_in != 23 || out_size != (int)O_TOTAL || ws_size < WS_END) { fprintf(stderr, "kernel_launch: unexpected shapes (n_in %d, out %d, ws %zu, need %zu)\n", n_in, out_size, ws_size, (size_t)WS_END); grid = -1; return; }
        int dev = 0, cus = 0;
        if (hipGetDevice(&dev) != hipSuccess || hipDeviceGetAttribute(&cus, hipDeviceAttributeMultiprocessorCount, dev) != hipSuccess) { grid = -1; return; }
        if (hipFuncSetAttribute((const void*)yoco_fwd, hipFuncAttributeMaxDynamicSharedMemorySize, LDS_BYTES) != hipSuccess) { fprintf(stderr, "kernel_launch: hipFuncSetAttribute failed\n"); grid = -1; return; }
        int per_cu = 0;
        if (hipOccupancyMaxActiveBlocksPerMultiprocessor(&per_cu, (const void*)yoco_fwd, NWAVES * 64, LDS_BYTES) != hipSuccess || per_cu < 1) fprintf(stderr, "kernel_launch: occupancy query reports %d\n", per_cu);
        (void)hipGetLastError();
        if (cus != 256) { fprintf(stderr, "kernel_launch: built for a 256-CU device (got %d)\n", cus); grid = -1; return; }
        grid = cus;
    }
    if (grid < 0) return;
    (void)hipMemsetAsync((char*)d_ws + WS_CTL, 0, CTL_ZERO_BYTES, stream);
    Args a{};
    const float* const* in = (const float* const*)d_in;
    a.xp = in[0]; a.xs = in[1]; a.state_ssm = in[2]; a.state_conv = in[3]; a.cache_k = in[4]; a.cache_v = in[5]; a.norm_mix = in[6]; a.norm_ffn = in[7]; a.a_w_in = in[8]; a.a_conv_w = in[9];
    a.a_log = in[10]; a.a_dt_bias = in[11]; a.a_o_norm = in[12]; a.a_w_out = in[13]; a.kv_norm = in[14]; a.w_kv = in[15]; a.k_norm = in[16]; a.b_w_q = in[17]; a.b_q_norm = in[18]; a.b_sinks = in[19];
    a.b_w_o = in[20]; a.ffn_w_gu = in[21]; a.ffn_w_down = in[22];
    a.out = (float*)d_out; a.ws = (unsigned char*)d_ws; a.ph_lo = 0; a.ph_hi = NPHASES;
    hipLaunchKernelGGL(yoco_fwd, dim3(grid), dim3(NWAVES * 64), LDS_BYTES, stream, a);
}
```
